# Optimizing an MI355X kernel written in HIP

```python
import jax, jax.numpy as jnp
from jax import lax
import numpy as np

D_MODEL = 1024
BATCH = 8
SEQ = 2048
DEPTH = 1
DEC_BATCH = 128
DEC_SEQ = 1
PAST_LEN = 16384
PAGE_SIZE = 128

N_MEM = 256
D_MIX = D_MODEL
D_CONV = D_MIX // 2
D_GLA = D_MIX - D_CONV
CONV_W = 31
GLA_HEADS = 4
GLA_DK = D_GLA // 2 // GLA_HEADS
GLA_DV = D_GLA // GLA_HEADS
GLA_RANK = 16
GLA_TAU = 16.0
GLA_CHUNK = 16
XA_HEADS = 4
XA_HD = D_MODEL // XA_HEADS
D_FF = 4 * D_MODEL
EPS = 1e-6
D_IN = 2 * D_CONV + 2 * GLA_HEADS * GLA_DK + GLA_HEADS * GLA_DV + D_GLA + GLA_RANK

kernel_name = 'hybrid_conformer_gla_xattn_decoder_step'


def rms_norm(x, g):
    xf = x.astype(jnp.float32)
    y = xf * lax.rsqrt(jnp.mean(xf * xf, axis=-1, keepdims=True) + EPS)
    return (y * g.astype(jnp.float32)).astype(x.dtype)


def layer_norm(x, g, b):
    xf = x.astype(jnp.float32)
    mu = jnp.mean(xf, axis=-1, keepdims=True)
    xc = xf - mu
    y = xc * lax.rsqrt(jnp.mean(xc * xc, axis=-1, keepdims=True) + EPS)
    return (y * g.astype(jnp.float32) + b.astype(jnp.float32)).astype(x.dtype)


def conformer_conv(u, prefix, w_dw, b_dw, ln_g, ln_b):
    full = jnp.concatenate([prefix.astype(u.dtype), u], axis=1)
    y = lax.conv_general_dilated(
        full, w_dw.astype(u.dtype)[:, None, :], window_strides=(1,), padding='VALID',
        dimension_numbers=('NWC', 'WIO', 'NWC'), feature_group_count=D_CONV)
    y = jax.nn.silu(layer_norm(y + b_dw, ln_g, ln_b))
    return y, full[:, -(CONV_W - 1):]


def gla_chunked(q, k, v, log_a, s0):
    B, T = q.shape[0], q.shape[1]
    n = -(-T // GLA_CHUNK)
    pad = n * GLA_CHUNK - T

    def blocks(t):
        t = jnp.pad(t.astype(jnp.float32), ((0, 0), (0, pad), (0, 0), (0, 0)))
        return t.reshape(B, n, GLA_CHUNK, t.shape[2], t.shape[3])

    q, k, v, log_a = blocks(q), blocks(k), blocks(v), blocks(log_a)
    b = jnp.cumsum(log_a, axis=2)
    causal = jnp.tril(jnp.ones((GLA_CHUNK, GLA_CHUNK), dtype=bool))
    diff = b[:, :, :, None] - b[:, :, None]
    decay = jnp.exp(jnp.where(causal[:, :, None, None], diff, -jnp.inf))
    scores = jnp.einsum('bnihd,bnjhd,bnijhd->bnhij', q, k, decay)
    o_intra = jnp.einsum('bnhij,bnjhv->bnihv', scores, v)

    b_last = b[:, :, -1]
    q_in = q * jnp.exp(b)
    k_in = k * jnp.exp(b_last[:, :, None] - b)
    chunk_kv = jnp.einsum('bnjhd,bnjhv->bnhdv', k_in, v)

    def step(S, xs):
        qc, dec, kv = xs
        o = jnp.einsum('bihd,bhdv->bihv', qc, S)
        S = jnp.exp(dec)[..., None] * S + kv
        return S, o

    S, o_inter = lax.scan(step, s0.astype(jnp.float32),
                          (jnp.moveaxis(q_in, 1, 0), jnp.moveaxis(b_last, 1, 0),
                           jnp.moveaxis(chunk_kv, 1, 0)))
    o = o_intra + jnp.moveaxis(o_inter, 0, 1)
    o = o.reshape(B, n * GLA_CHUNK, o.shape[3], o.shape[4])[:, :T]
    return o, S


def token_mix(h, conv_prefix, s0, w_in, w_alpha, b_alpha, w_dw, b_dw, ln_g, ln_b,
              gla_g, w_out):
    B, T, _ = h.shape
    proj = h @ w_in
    i1 = D_CONV
    i2 = 2 * D_CONV
    i3 = i2 + GLA_HEADS * GLA_DK
    i4 = i3 + GLA_HEADS * GLA_DK
    i5 = i4 + GLA_HEADS * GLA_DV
    i6 = i5 + D_GLA
    c_val, c_gate, q, k, v, r, a_lr = jnp.split(proj, [i1, i2, i3, i4, i5, i6], axis=-1)
    u = c_val * jax.nn.sigmoid(c_gate)
    conv_out, conv_state = conformer_conv(u, conv_prefix, w_dw, b_dw, ln_g, ln_b)
    log_a = jax.nn.log_sigmoid((a_lr @ w_alpha + b_alpha).astype(jnp.float32)) / GLA_TAU
    o, s_new = gla_chunked(
        q.reshape(B, T, GLA_HEADS, GLA_DK) * (GLA_DK ** -0.5),
        k.reshape(B, T, GLA_HEADS, GLA_DK),
        v.reshape(B, T, GLA_HEADS, GLA_DV),
        log_a.reshape(B, T, GLA_HEADS, GLA_DK), s0)
    o = rms_norm(o, gla_g).astype(h.dtype).reshape(B, T, D_GLA) * jax.nn.silu(r)
    out = jnp.concatenate([conv_out, o], axis=-1) @ w_out
    return out, conv_state, s_new


def memory_kv(mem, g, w_k, w_v):
    B = mem.shape[0]
    m = rms_norm(mem, g)
    mk = (m @ w_k).reshape(B, N_MEM, XA_HEADS, XA_HD)
    mv = (m @ w_v).reshape(B, N_MEM, XA_HEADS, XA_HD)
    return mk, mv


def cross_attn(h, mk, mv, w_q, w_o):
    B, T, _ = h.shape
    q = (h @ w_q).reshape(B, T, XA_HEADS, XA_HD)
    s = jnp.einsum('bthd,bmhd->bhtm', q, mk).astype(jnp.float32) * (XA_HD ** -0.5)
    p = jax.nn.softmax(s, axis=-1).astype(mv.dtype)
    o = jnp.einsum('bhtm,bmhd->bthd', p, mv).reshape(B, T, D_MODEL)
    return o @ w_o


def setup_inputs(seed: int = 0) -> dict:
    key = jax.random.key(seed)
    ks = jax.random.split(key, 32)
    f32 = jnp.float32

    def nrm(k, shape, scale):
        return scale * jax.random.normal(k, shape, f32)

    return {
        'x_prompt': nrm(ks[0], (BATCH, SEQ, D_MODEL), 1.0),
        'x_sample': nrm(ks[1], (DEC_BATCH, DEC_SEQ, D_MODEL), 1.0),
        'cache_conv': nrm(ks[2], (DEPTH, DEC_BATCH, CONV_W - 1, D_CONV), 0.5),
        'state_gla': nrm(ks[3], (DEPTH, DEC_BATCH, GLA_HEADS, GLA_DK, GLA_DV), 1.0),
        'cache_mem_k': nrm(ks[4], (DEPTH, DEC_BATCH, N_MEM, XA_HEADS, XA_HD), 1.0),
        'cache_mem_v': nrm(ks[5], (DEPTH, DEC_BATCH, N_MEM, XA_HEADS, XA_HD), 1.0),
        'mem_prompt': nrm(ks[6], (BATCH, N_MEM, D_MODEL), 1.0),
        'norm_mix_g': 1.0 + nrm(ks[7], (DEPTH, D_MODEL), 0.02),
        'w_in': nrm(ks[8], (DEPTH, D_MODEL, D_IN), D_MODEL ** -0.5),
        'w_alpha': nrm(ks[9], (DEPTH, GLA_RANK, GLA_HEADS * GLA_DK), GLA_RANK ** -0.5),
        'b_alpha': nrm(ks[10], (DEPTH, GLA_HEADS * GLA_DK), 0.1),
        'w_dw': nrm(ks[11], (DEPTH, CONV_W, D_CONV), CONV_W ** -0.5),
        'b_dw': nrm(ks[12], (DEPTH, D_CONV), 0.02),
        'conv_ln_g': 1.0 + nrm(ks[13], (DEPTH, D_CONV), 0.02),
        'conv_ln_b': nrm(ks[14], (DEPTH, D_CONV), 0.02),
        'gla_norm_g': 1.0 + nrm(ks[15], (DEPTH, GLA_DV), 0.02),
        'w_out': nrm(ks[16], (DEPTH, D_MIX, D_MODEL), D_MIX ** -0.5),
        'norm_xa_g': 1.0 + nrm(ks[17], (DEPTH, D_MODEL), 0.02),
        'mem_norm_g': 1.0 + nrm(ks[18], (DEPTH, D_MODEL), 0.02),
        'w_xq': nrm(ks[19], (DEPTH, D_MODEL, D_MODEL), D_MODEL ** -0.5),
        'w_xk': nrm(ks[20], (DEPTH, D_MODEL, D_MODEL), D_MODEL ** -0.5),
        'w_xv': nrm(ks[21], (DEPTH, D_MODEL, D_MODEL), D_MODEL ** -0.5),
        'w_xo': nrm(ks[22], (DEPTH, D_MODEL, D_MODEL), D_MODEL ** -0.5),
        'norm_ffn_g': 1.0 + nrm(ks[23], (DEPTH, D_MODEL), 0.02),
        'w_up': nrm(ks[24], (DEPTH, D_MODEL, D_FF), D_MODEL ** -0.5),
        'w_down': nrm(ks[25], (DEPTH, D_FF, D_MODEL), D_FF ** -0.5),
        'final_g': 1.0 + nrm(ks[26], (D_MODEL,), 0.02),
    }


def reference(x_prompt, x_sample, cache_conv, state_gla, cache_mem_k, cache_mem_v,
              mem_prompt, norm_mix_g, w_in, w_alpha, b_alpha, w_dw, b_dw, conv_ln_g,
              conv_ln_b, gla_norm_g, w_out, norm_xa_g, mem_norm_g, w_xq, w_xk, w_xv,
              w_xo, norm_ffn_g, w_up, w_down, final_g):

    def run_layer(x, l, conv_prefix, s0, mk, mv):
        m, conv_state, s_new = token_mix(
            rms_norm(x, norm_mix_g[l]), conv_prefix, s0, w_in[l], w_alpha[l], b_alpha[l],
            w_dw[l], b_dw[l], conv_ln_g[l], conv_ln_b[l], gla_norm_g[l], w_out[l])
        x = x + m
        x = x + cross_attn(rms_norm(x, norm_xa_g[l]), mk, mv, w_xq[l], w_xo[l])
        h = rms_norm(x, norm_ffn_g[l])
        x = x + jnp.square(jax.nn.relu(h @ w_up[l])) @ w_down[l]
        return x, conv_state, s_new

    xp = x_prompt
    conv_p, gla_p, mk_p, mv_p = [], [], [], []
    for l in range(DEPTH):
        mk, mv = memory_kv(mem_prompt, mem_norm_g[l], w_xk[l], w_xv[l])
        prefix0 = jnp.zeros((xp.shape[0], CONV_W - 1, D_CONV), xp.dtype)
        s00 = jnp.zeros((xp.shape[0], GLA_HEADS, GLA_DK, GLA_DV), jnp.float32)
        xp, cs, ss = run_layer(xp, l, prefix0, s00, mk, mv)
        conv_p.append(cs)
        gla_p.append(ss)
        mk_p.append(mk)
        mv_p.append(mv)
    y_prompt = rms_norm(xp, final_g)

    xs = x_sample
    conv_s, gla_s = [], []
    for l in range(DEPTH):
        xs, cs, ss = run_layer(xs, l, cache_conv[l], state_gla[l], cache_mem_k[l], cache_mem_v[l])
        conv_s.append(cs)
        gla_s.append(ss)
    y_sample = rms_norm(xs, final_g)

    conv_prompt = jnp.stack(conv_p)
    conv_sample = jnp.stack(conv_s)
    gla_prompt = jnp.stack(gla_p)
    gla_sample = jnp.stack(gla_s)
    mem_k_prompt = jnp.stack(mk_p)
    mem_v_prompt = jnp.stack(mv_p)
    return (y_prompt, y_sample, conv_prompt, conv_sample, gla_prompt, gla_sample, mem_k_prompt, mem_v_prompt)
```

```cpp
#include <hip/hip_runtime.h>
#include <hip/hip_cooperative_groups.h>
#include <cstdio>
#include <cstdint>
namespace cg = cooperative_groups;
namespace pg8 {
#define PG8_LAS __attribute__((address_space(3)))
typedef unsigned short bf16_t;
typedef short bf16x8 __attribute__((ext_vector_type(8)));
typedef float f32x4 __attribute__((ext_vector_type(4)));
typedef unsigned u32x4 __attribute__((ext_vector_type(4)));
constexpr int BM = 256, BK = 64, HALF = 128, HTB = HALF * BK * 2  , STAGE_BYTES = 8 * HTB, NXCD = 8, WGM = 8;

__host__ __device__ __forceinline__ int lds_byte(int r, int c) { const int st = (r >> 4) * 2 + (c >> 5), rr = r & 15, cc = c & 31, ob = rr * 64 + cc * 2; return st * 1024 + (ob ^ (((ob >> 9) & 1) << 5)); }
__host__ __device__ __forceinline__ void stage_rc(int b, int& R, int& C) { const int st = b / 1024, sb = b % 1024, swz = sb ^ (((sb >> 9) & 1) << 5); R = (st >> 1) * 16 + swz / 64; C = (st & 1) * 32 + (swz % 64) / 2; }
__host__ __device__ __forceinline__ int perm32(int rho) { const int n = rho >> 4, i = rho & 15; return 8 * (i >> 2) + 4 * n + (i & 3); }

struct Unit { int pm, pn; };
struct Gemm { const bf16_t* A; const bf16_t* Bt; int M, N, K; };
__device__ __forceinline__ unsigned cvt_pk_bf16(float lo, float hi) { unsigned r; asm volatile("v_cvt_pk_bf16_f32 %0, %1, %2" : "=v"(r) : "v"(lo), "v"(hi)); return r; }
template <class Epi, class Sched, bool ALIGN_EPI = false, bool SP2 = false>
__device__ __forceinline__ void gemm_phase(PG8_LAS unsigned char* lds, const Gemm g, const Sched& S, const Epi& E) {
    const int tid = threadIdx.x, wid = __builtin_amdgcn_readfirstlane(tid >> 6), lane = tid & 63, wr = wid >> 2, wc = wid & 3, fr = lane & 15, fq = lane >> 4;
    const int K = g.K, nt = K / BK;
    unsigned voffA[2], voffB[2];
#pragma unroll
    for (int i = 0; i < 2; ++i) { int R, C; stage_rc(tid * 16 + i * 8192, R, C); const int Rb = Epi::PERM ? ((R & ~31) + perm32(R & 31)) : R;
        voffA[i] = (unsigned)(R * K + C) * 2u; voffB[i] = (unsigned)(Rb * K + C) * 2u; }
    const size_t kstep = (size_t)(BK * 2);
    const size_t hstep = (size_t)HALF * K * 2;
    const size_t tstep = 2 * hstep;
    const unsigned ldsw = (unsigned)wid * 1024u;
    const int aoff = lds_byte(wr * 64 + fr, fq * 8), boff = lds_byte(wc * 32 + fr, fq * 8);
#define PG8_SA(b, h) (((b) * 2 + (h)) * HTB)
#define PG8_SB(b, h) ((4 + (b) * 2 + (h)) * HTB)
#define PG8_STAGE(bufoff, gbase, voff) do { _Pragma("unroll") for (int _i = 0; _i < 2; ++_i) \
        __builtin_amdgcn_global_load_lds((const unsigned*)((const char*)(gbase) + (voff)[_i]), (PG8_LAS unsigned*)(lds + (bufoff) + ldsw + _i * 8192), 16, 0, 0); } while (0)
#define PG8_LDA(dst, b, h) do { _Pragma("unroll") for (int m = 0; m < 4; ++m) _Pragma("unroll") for (int k = 0; k < 2; ++k) dst[m][k] = *(const PG8_LAS bf16x8*)(lds + PG8_SA(b, h) + aoff + m * 2048 + k * 1024); } while (0)
#define PG8_LDB(dst, b, h) do { _Pragma("unroll") for (int n = 0; n < 2; ++n) _Pragma("unroll") for (int k = 0; k < 2; ++k) dst[n][k] = *(const PG8_LAS bf16x8*)(lds + PG8_SB(b, h) + boff + n * 2048 + k * 1024); } while (0)
#define PG8_MMA(ai, bj, At, Bt) do { __builtin_amdgcn_s_setprio(1); _Pragma("unroll") for (int m = 0; m < 4; ++m) _Pragma("unroll") for (int n = 0; n < 2; ++n) _Pragma("unroll") for (int k = 0; k < 2; ++k) \
        acc[ai][bj][m][n] = __builtin_amdgcn_mfma_f32_16x16x32_bf16(Bt[n][k], At[m][k], acc[ai][bj][m][n], 0, 0, 0); __builtin_amdgcn_s_setprio(0); } while (0)
#define PG8_WAIT_V(n) asm volatile("s_waitcnt vmcnt(" #n ")" ::: "memory")
#define PG8_WAIT_L(n) asm volatile("s_waitcnt lgkmcnt(" #n ")" ::: "memory")
#define PG8_BAR __builtin_amdgcn_s_barrier()
#define PG8_SCHED __builtin_amdgcn_sched_barrier(0)
    Unit cur, nxt; int ui = 0;
    if (!S.next(0, cur)) return;
    f32x4 acc[2][2][4][2];
#pragma unroll
    for (int a = 0; a < 2; ++a)
#pragma unroll
        for (int b = 0; b < 2; ++b)
#pragma unroll
            for (int m = 0; m < 4; ++m)
#pragma unroll
                for (int n = 0; n < 2; ++n) acc[a][b][m][n] = (f32x4){0.f, 0.f, 0.f, 0.f};
    bf16x8 At[4][2], B0[2][2], B1[2][2];
    const char* cA = (const char*)g.A + (size_t)cur.pm * tstep; const char* cB = (const char*)g.Bt + (size_t)cur.pn * tstep;
    S.a_ready(cur);
    if constexpr (SP2) {
        PG8_STAGE(PG8_SB(0, 0), cB, voffB); PG8_STAGE(PG8_SB(0, 1), cB + hstep, voffB); PG8_STAGE(PG8_SA(0, 0), cA, voffA); PG8_STAGE(PG8_SA(0, 1), cA + hstep, voffA);
        if (wr == 1) PG8_BAR;
        PG8_WAIT_V(2); PG8_BAR;
        PG8_STAGE(PG8_SB(1, 0), cB + kstep, voffB); PG8_STAGE(PG8_SA(1, 0), cA + kstep, voffA); PG8_STAGE(PG8_SB(1, 1), cB + hstep + kstep, voffB);
        PG8_WAIT_V(6); PG8_BAR;
    } else {
        PG8_STAGE(PG8_SB(0, 0), cB, voffB); PG8_STAGE(PG8_SA(0, 0), cA, voffA); PG8_STAGE(PG8_SB(0, 1), cB + hstep, voffB); PG8_STAGE(PG8_SA(0, 1), cA + hstep, voffA);
        if (wr == 1) PG8_BAR;
        PG8_WAIT_V(4); PG8_BAR;
        PG8_STAGE(PG8_SB(1, 0), cB + kstep, voffB); PG8_STAGE(PG8_SA(1, 0), cA + kstep, voffA); PG8_STAGE(PG8_SB(1, 1), cB + hstep + kstep, voffB);
        PG8_WAIT_V(6); PG8_BAR;
    }
    for (;;) {
        const bool has_next = S.next(ui + 1, nxt);
        const char* nA = has_next ? (const char*)g.A + (size_t)nxt.pm * tstep : cA; const char* nB = has_next ? (const char*)g.Bt + (size_t)nxt.pn * tstep : cB;
        for (int t = 0; t < nt; t += 2) {
            const bool last = (t == nt - 2);
            const char* a1 = cA + (size_t)(t + 1) * kstep;
            const char* a2 = last ? nA : cA + (size_t)(t + 2) * kstep; const char* b2 = last ? nB : cB + (size_t)(t + 2) * kstep;
            const char* a3 = a2 + kstep; const char* b3 = b2 + kstep;
            if (last && has_next) S.a_ready(nxt);
            if constexpr (SP2) {
            PG8_LDB(B0, 0, 0); PG8_LDB(B1, 0, 1); PG8_SCHED; PG8_LDA(At, 0, 0); PG8_STAGE(PG8_SA(1, 1), a1 + hstep, voffA);
            PG8_WAIT_V(8); PG8_WAIT_L(0); PG8_BAR; PG8_MMA(0, 0, At, B0); PG8_MMA(0, 1, At, B1); PG8_BAR; PG8_SCHED;
            PG8_LDA(At, 0, 1); PG8_STAGE(PG8_SB(0, 0), b2, voffB); PG8_STAGE(PG8_SB(0, 1), b2 + hstep, voffB); PG8_STAGE(PG8_SA(0, 0), a2, voffA);
            PG8_WAIT_V(8); PG8_WAIT_L(0); PG8_BAR; PG8_MMA(1, 0, At, B0); PG8_MMA(1, 1, At, B1); PG8_BAR; PG8_SCHED;
            PG8_LDB(B0, 1, 0); PG8_LDB(B1, 1, 1); PG8_SCHED; PG8_LDA(At, 1, 0); PG8_STAGE(PG8_SA(0, 1), a2 + hstep, voffA);
            PG8_WAIT_V(8); PG8_WAIT_L(0); PG8_BAR; PG8_MMA(0, 0, At, B0); PG8_MMA(0, 1, At, B1); PG8_BAR; PG8_SCHED;
            PG8_LDA(At, 1, 1); PG8_STAGE(PG8_SB(1, 0), b3, voffB); PG8_STAGE(PG8_SB(1, 1), b3 + hstep, voffB); PG8_STAGE(PG8_SA(1, 0), a3, voffA);
            PG8_WAIT_V(8); PG8_WAIT_L(0); PG8_BAR; PG8_MMA(1, 0, At, B0); PG8_MMA(1, 1, At, B1); PG8_BAR; PG8_SCHED;
            } else {
            PG8_LDB(B0, 0, 0); PG8_SCHED; PG8_LDA(At, 0, 0); PG8_STAGE(PG8_SA(1, 1), a1 + hstep, voffA);
            PG8_WAIT_L(8); PG8_BAR; PG8_WAIT_L(0); PG8_MMA(0, 0, At, B0); PG8_BAR; PG8_SCHED;
            PG8_LDB(B1, 0, 1); PG8_STAGE(PG8_SB(0, 0), b2, voffB);
            PG8_BAR; PG8_WAIT_L(0); PG8_MMA(0, 1, At, B1); PG8_BAR;
            PG8_LDA(At, 0, 1); PG8_STAGE(PG8_SA(0, 0), a2, voffA);
            PG8_BAR; PG8_WAIT_L(0); PG8_MMA(1, 0, At, B0); PG8_BAR; PG8_SCHED;
            PG8_STAGE(PG8_SB(0, 1), b2 + hstep, voffB);
            PG8_WAIT_V(6); PG8_BAR; PG8_MMA(1, 1, At, B1); PG8_BAR;
            PG8_LDB(B0, 1, 0); PG8_SCHED; PG8_LDA(At, 1, 0); PG8_STAGE(PG8_SA(0, 1), a2 + hstep, voffA);
            PG8_WAIT_L(8); PG8_BAR; PG8_WAIT_L(0); PG8_MMA(0, 0, At, B0); PG8_BAR; PG8_SCHED;
            PG8_LDB(B1, 1, 1); PG8_STAGE(PG8_SB(1, 0), b3, voffB);
            PG8_BAR; PG8_WAIT_L(0); PG8_MMA(0, 1, At, B1); PG8_BAR;
            PG8_LDA(At, 1, 1); PG8_STAGE(PG8_SA(1, 0), a3, voffA);
            PG8_BAR; PG8_WAIT_L(0); PG8_MMA(1, 0, At, B0); PG8_BAR; PG8_SCHED;
            PG8_STAGE(PG8_SB(1, 1), b3 + hstep, voffB);
            PG8_WAIT_V(6); PG8_BAR; PG8_MMA(1, 1, At, B1); PG8_BAR;
            }
        }
        if constexpr (ALIGN_EPI) { if (wr == 0) PG8_BAR; }
        if constexpr (!Epi::AFTER_DRAIN) { E(acc, cur, wr, wc, fr, fq); S.done(cur); }
        if (!has_next) break;
#pragma unroll
        for (int a = 0; a < 2; ++a)
#pragma unroll
            for (int b = 0; b < 2; ++b)
#pragma unroll
                for (int m = 0; m < 4; ++m)
#pragma unroll
                    for (int n = 0; n < 2; ++n) acc[a][b][m][n] = (f32x4){0.f, 0.f, 0.f, 0.f};
        cur = nxt; cA = nA; cB = nB; ++ui;
        if constexpr (ALIGN_EPI) { if (wr == 1) PG8_BAR; }
    }
    PG8_WAIT_V(0);
    if constexpr (!ALIGN_EPI) { if (wr == 0) PG8_BAR; }
    PG8_BAR;
    if constexpr (Epi::AFTER_DRAIN) { E.fused(acc, cur, wr, wc, fr, fq, lds, wid, lane); S.done(cur); }
#undef PG8_SA
#undef PG8_SB
#undef PG8_STAGE
#undef PG8_LDA
#undef PG8_LDB
#undef PG8_MMA
#undef PG8_WAIT_V
#undef PG8_WAIT_L
#undef PG8_BAR
#undef PG8_SCHED
}
}

#define LAS __attribute__((address_space(3)))
typedef unsigned short bf16;
typedef pg8::bf16x8 bf16x8;
typedef pg8::f32x4 f32x4;
typedef pg8::u32x4 u32x4;
typedef float f32x16 __attribute__((ext_vector_type(16)));
typedef unsigned u32x2 __attribute__((ext_vector_type(2)));
using pg8::cvt_pk_bf16;

constexpr int NP = 16384, NS = 128, NROW = NP + NS, MALL = 16640, D = 1024, FF = 4096, TSEQ = 2048;
constexpr int NIN = 2816;
constexpr int PJ = 2048;
constexpr int PJ_Q = 512, PJ_K = 768, PJ_V = 1024, PJ_R = 1536;
constexpr float EPS = 1e-6f;
constexpr int NCHUNK = 32, CH = 64;

constexpr size_t MiB = 1u << 20;
constexpr size_t WS_PART = 1 * MiB;
constexpr size_t PART_BYTES = (size_t)MALL * 16 * 4;
constexpr size_t WS_DEC = 5 * MiB;
constexpr size_t WS_WCAT = 6 * MiB;
constexpr size_t WS_WOUT = 16 * MiB, WS_WXQ = 18 * MiB, WS_WXO = 20 * MiB, WS_WUP = 22 * MiB, WS_WDN = 30 * MiB;
constexpr size_t WS_MKB = 38 * MiB, WS_MVB = 42 * MiB, WS_MVT = 46 * MiB;
constexpr size_t WS_XN = 50 * MiB;
constexpr size_t WS_LA = 87 * MiB;
constexpr size_t WS_X1 = 104 * MiB;
constexpr size_t WS_XB = 169 * MiB;
constexpr size_t WS_QX = 202 * MiB;
constexpr size_t WS_AO = 235 * MiB;
constexpr size_t WS_SB = 268 * MiB;
constexpr size_t WS_PROJ = 284 * MiB;
constexpr size_t WS_MIX = 349 * MiB;
constexpr size_t WS_KV = 382 * MiB;
constexpr size_t WS_HB = 284 * MiB;
constexpr size_t WS_END = 414 * MiB;

constexpr size_t O_YP = 0, O_YS = 16777216, O_CP = 16908288, O_CS = 17031168, O_GP = 18997248, O_GS = 19259392, O_MK = 23453696, O_MV = 25550848;

constexpr int LDS_BYTES = 147456;

__device__ __forceinline__ float bf2f(unsigned short b) { return __uint_as_float(((unsigned)b) << 16); }
__device__ __forceinline__ float bflo(unsigned w) { return __uint_as_float(w << 16); }
__device__ __forceinline__ float bfhi(unsigned w) { return __uint_as_float(w & 0xffff0000u); }
__device__ __forceinline__ unsigned short f2bf(float f) { return (unsigned short)(cvt_pk_bf16(f, 0.f) & 0xffffu); }
__device__ __forceinline__ float sigmoidf_(float x) { return 1.0f / (1.0f + __expf(-x)); }
__device__ __forceinline__ float siluf_(float x) { return x / (1.0f + __expf(-x)); }
__device__ __forceinline__ float wave_sum(float v) {
#pragma unroll
    for (int o = 1; o < 64; o <<= 1) v += __shfl_xor(v, o);
    return v;
}
__device__ __forceinline__ float wave_max(float v) {
#pragma unroll
    for (int o = 1; o < 64; o <<= 1) v = fmaxf(v, __shfl_xor(v, o));
    return v;
}
__device__ __forceinline__ u32x4 pack8(f32x4 a, f32x4 b) { u32x4 w; w.x = cvt_pk_bf16(a[0], a[1]); w.y = cvt_pk_bf16(a[2], a[3]); w.z = cvt_pk_bf16(b[0], b[1]); w.w = cvt_pk_bf16(b[2], b[3]); return w; }
#define LDS_WAIT() asm volatile("s_waitcnt lgkmcnt(0)" ::: "memory")

struct Args { const float* in[27]; float* out; unsigned char* ws; int ph_lo, ph_hi; };

struct OrderRect {
    int nM, nN, nwg, G, c, n2M, n2N, pm2, pn2;
    __device__ void init(int nM_, int nN_, int G_, int c_, int n2M_ = 0, int n2N_ = 0, int pm2_ = 0, int pn2_ = 0) { nM = nM_; nN = nN_; nwg = nM * nN; G = G_; c = c_; n2M = n2M_; n2N = n2N_; pm2 = pm2_; pn2 = pn2_; }
    __device__ bool next(int i, pg8::Unit& u) const {
        long L = (long)i * G + c;
        if (L < nwg) {
            int wgid = (int)L; { const int q = nwg / 8, r = nwg % 8, xcd = wgid % 8, off = wgid / 8; wgid = (xcd < r ? xcd * (q + 1) : r * (q + 1) + (xcd - r) * q) + off; }
            const int nig = 8 * nN, gid = wgid / nig, fm = gid * 8, gsz = (nM - fm) < 8 ? (nM - fm) : 8;
            u.pm = fm + ((wgid % nig) % gsz); u.pn = (wgid % nig) / gsz; return true;
        }
        L -= nwg;
        if (L < (long)n2M * n2N) { u.pm = pm2 + (int)(L % n2M); u.pn = pn2 + (int)(L / n2M); return true; }
        return false;
    }
    __device__ __forceinline__ void a_ready(const pg8::Unit&) const {}
    __device__ __forceinline__ void done(const pg8::Unit&) const {}
};

struct EpiG1 {
    static constexpr bool PERM = true, AFTER_DRAIN = false;
    bf16* proj; float* la; const float* b_alpha; float* conv_p; float* conv_s; float* mk_out; float* mv_out; bf16* mkb; bf16* mvb;
    __device__ __forceinline__ void operator()(const f32x4 (&acc)[2][2][4][2], const pg8::Unit& u, int wr, int wc, int fr, int fq) const {
        const int pm = u.pm, pn = u.pn;
        if (pm < 65) {
            if (pn < 4) {
                const int ch = 128 * pn + 32 * wc + 8 * fq;
#pragma unroll
                for (int ai = 0; ai < 2; ++ai) {
                    if (256 * pm + 128 * ai >= NROW) continue;
#pragma unroll
                    for (int m = 0; m < 4; ++m) {
                        const int row = 256 * pm + 128 * ai + 64 * wr + 16 * m + fr;
                        f32x4 u0, u1;
#pragma unroll
                        for (int j = 0; j < 4; ++j) { u0[j] = acc[ai][0][m][0][j] * sigmoidf_(acc[ai][1][m][0][j]); u1[j] = acc[ai][0][m][1][j] * sigmoidf_(acc[ai][1][m][1][j]); }
                        *(u32x4*)(proj + (size_t)row * PJ + ch) = pack8(u0, u1);
                        if (row < NP) { const int t = row & (TSEQ - 1); if (t >= TSEQ - 30) { float* p = conv_p + ((size_t)((row >> 11) * 30 + (t - (TSEQ - 30)))) * 512 + ch; *(f32x4*)p = u0; *(f32x4*)(p + 4) = u1; } }
                        else { float* p = conv_s + ((size_t)((row - NP) * 30 + 29)) * 512 + ch; *(f32x4*)p = u0; *(f32x4*)(p + 4) = u1; }
                    }
                }
            } else if (pn < 10) {
                const bool act = pn >= 8;
#pragma unroll
                for (int ai = 0; ai < 2; ++ai) {
                    if (256 * pm + 128 * ai >= NROW) continue;
#pragma unroll
                    for (int m = 0; m < 4; ++m) {
                        const int row = 256 * pm + 128 * ai + 64 * wr + 16 * m + fr;
#pragma unroll
                        for (int bj = 0; bj < 2; ++bj) {
                            const int col = 512 + 256 * (pn - 4) + 128 * bj + 32 * wc + 8 * fq;
                            f32x4 v0 = acc[ai][bj][m][0], v1 = acc[ai][bj][m][1];
                            if (act) {
#pragma unroll
                                for (int j = 0; j < 4; ++j) { v0[j] = siluf_(v0[j]); v1[j] = siluf_(v1[j]); }
                            }
                            *(u32x4*)(proj + (size_t)row * PJ + col) = pack8(v0, v1);
                        }
                    }
                }
            } else {
#pragma unroll
                for (int bj = 0; bj < 2; ++bj) {
                    const int c = 128 * bj + 32 * wc + 8 * fq;
                    const f32x4 b0 = *(const f32x4*)(b_alpha + c), b1 = *(const f32x4*)(b_alpha + c + 4);
#pragma unroll
                    for (int ai = 0; ai < 2; ++ai) {
                        if (256 * pm + 128 * ai >= NROW) continue;
#pragma unroll
                        for (int m = 0; m < 4; ++m) {
                            const int row = 256 * pm + 128 * ai + 64 * wr + 16 * m + fr;
                            f32x4 z0 = acc[ai][bj][m][0] + b0, z1 = acc[ai][bj][m][1] + b1;
#pragma unroll
                            for (int j = 0; j < 4; ++j) {
                                z0[j] = (fminf(z0[j], 0.f) - __logf(1.0f + __expf(-fabsf(z0[j])))) * 0.0625f;
                                z1[j] = (fminf(z1[j], 0.f) - __logf(1.0f + __expf(-fabsf(z1[j])))) * 0.0625f;
                            }
                            float* p = la + (size_t)row * 256 + c; *(f32x4*)p = z0; *(f32x4*)(p + 4) = z1;
                        }
                    }
                }
            }
        } else {
            const int cb = 256 * (pn - 11);
            const bool isk = cb < 1024;
            float* of = isk ? mk_out : mv_out; bf16* ob = isk ? mkb : mvb; const int c0 = isk ? cb : cb - 1024;
#pragma unroll
            for (int ai = 0; ai < 2; ++ai)
#pragma unroll
                for (int m = 0; m < 4; ++m) {
                    const int row = 256 * (pm - 65) + 128 * ai + 64 * wr + 16 * m + fr;
#pragma unroll
                    for (int bj = 0; bj < 2; ++bj) {
                        const int col = c0 + 128 * bj + 32 * wc + 8 * fq;
                        const f32x4 v0 = acc[ai][bj][m][0], v1 = acc[ai][bj][m][1];
                        float* p = of + (size_t)row * 1024 + col; *(f32x4*)p = v0; *(f32x4*)(p + 4) = v1;
                        *(u32x4*)(ob + (size_t)row * 1024 + col) = pack8(v0, v1);
                    }
                }
        }
    }
};

struct EpiRes {
    static constexpr bool PERM = true, AFTER_DRAIN = false;
    const float* rp; const float* rs; float* op; float* os; bf16* ob; float* part;
    __device__ __forceinline__ void operator()(const f32x4 (&acc)[2][2][4][2], const pg8::Unit& u, int wr, int wc, int fr, int fq) const {
        const int pm = u.pm, pn = u.pn;
#pragma unroll
        for (int ai = 0; ai < 2; ++ai) {
            if (256 * pm + 128 * ai >= NROW) continue;
#pragma unroll
            for (int m = 0; m < 4; ++m) {
                const int row = 256 * pm + 128 * ai + 64 * wr + 16 * m + fr;
                const float* rr = row < NP ? rp + (size_t)row * D : rs + (size_t)(row - NP) * D;
                float* oo = row < NP ? op + (size_t)row * D : os + (size_t)(row - NP) * D;
                float ss = 0.f;
#pragma unroll
                for (int bj = 0; bj < 2; ++bj) {
                    const int col = 256 * pn + 128 * bj + 32 * wc + 8 * fq;
                    const f32x4 x0 = *(const f32x4*)(rr + col) + acc[ai][bj][m][0], x1 = *(const f32x4*)(rr + col + 4) + acc[ai][bj][m][1];
                    *(f32x4*)(oo + col) = x0; *(f32x4*)(oo + col + 4) = x1;
                    if (ob) *(u32x4*)(ob + (size_t)row * D + col) = pack8(x0, x1);
                    ss += (x0[0] * x0[0] + x0[1] * x0[1]) + (x0[2] * x0[2] + x0[3] * x0[3]) + (x1[0] * x1[0] + x1[1] * x1[1]) + (x1[2] * x1[2] + x1[3] * x1[3]);
                }
                ss += __shfl_xor(ss, 16); ss += __shfl_xor(ss, 32);
                if (fq == 0) part[(size_t)row * 16 + pn * 4 + wc] = ss;
            }
        }
    }
};

template <int MODE  > struct EpiScale {
    static constexpr bool PERM = true, AFTER_DRAIN = false;
    const float* part; bf16* o; int ldc;
    __device__ __forceinline__ void operator()(const f32x4 (&acc)[2][2][4][2], const pg8::Unit& u, int wr, int wc, int fr, int fq) const {
        const int pm = u.pm, pn = u.pn;
#pragma unroll
        for (int ai = 0; ai < 2; ++ai) {
            if (256 * pm + 128 * ai >= NROW) continue;
#pragma unroll
            for (int m = 0; m < 4; ++m) {
                const int row = 256 * pm + 128 * ai + 64 * wr + 16 * m + fr;
                const f32x4* pp = (const f32x4*)(part + (size_t)row * 16);
                const f32x4 p0 = pp[0], p1 = pp[1], p2 = pp[2], p3 = pp[3];
                const f32x4 ps = (p0 + p1) + (p2 + p3);
                const float rstd = rsqrtf(((ps[0] + ps[1]) + (ps[2] + ps[3])) * (1.0f / D) + EPS);
#pragma unroll
                for (int bj = 0; bj < 2; ++bj) {
                    const int col = 256 * pn + 128 * bj + 32 * wc + 8 * fq;
                    f32x4 v0 = acc[ai][bj][m][0] * rstd, v1 = acc[ai][bj][m][1] * rstd;
                    if (MODE == 1) {
#pragma unroll
                        for (int j = 0; j < 4; ++j) { const float a = fmaxf(v0[j], 0.f), b = fmaxf(v1[j], 0.f); v0[j] = a * a; v1[j] = b * b; }
                    }
                    *(u32x4*)(o + (size_t)row * ldc + col) = pack8(v0, v1);
                }
            }
        }
    }
};

__device__ __forceinline__ void transpose_item(const float* W, int N, int K, bf16* WT, int k0, int n0, int drow0, const float* gk, float sc, LAS float* scr, int lane) {
#pragma unroll 8
    for (int i = 0; i < 32; ++i) { const int kk = 2 * i + (lane >> 5); const float g = gk ? gk[k0 + kk] * sc : sc; scr[kk * 33 + (lane & 31)] = W[(size_t)(k0 + kk) * N + n0 + (lane & 31)] * g; }
    LDS_WAIT(); asm volatile("" ::: "memory");
    const int c = lane & 7;
#pragma unroll
    for (int j = 0; j < 4; ++j) { const int n = (lane >> 3) + 8 * j; const LAS float* s = scr + (8 * c) * 33 + n;
        u32x4 o; o.x = cvt_pk_bf16(s[0 * 33], s[1 * 33]); o.y = cvt_pk_bf16(s[2 * 33], s[3 * 33]); o.z = cvt_pk_bf16(s[4 * 33], s[5 * 33]); o.w = cvt_pk_bf16(s[6 * 33], s[7 * 33]);
        *(u32x4*)(WT + (size_t)(drow0 + n) * K + k0 + 8 * c) = o; }
    LDS_WAIT(); asm volatile("" ::: "memory");
}
__device__ __forceinline__ void norm_row_bf16(const float* xrow, const float* g, bf16* orow, int lane) {
    f32x4 v[4]; float s = 0.f;
#pragma unroll
    for (int j = 0; j < 4; ++j) { v[j] = ((const f32x4*)xrow)[lane + 64 * j]; s += (v[j][0] * v[j][0] + v[j][1] * v[j][1]) + (v[j][2] * v[j][2] + v[j][3] * v[j][3]); }
    const float rstd = rsqrtf(wave_sum(s) * (1.0f / D) + EPS);
#pragma unroll
    for (int j = 0; j < 4; ++j) { const f32x4 gv = ((const f32x4*)g)[lane + 64 * j]; const f32x4 o = v[j] * rstd * gv; u32x2 w; w.x = cvt_pk_bf16(o[0], o[1]); w.y = cvt_pk_bf16(o[2], o[3]); ((u32x2*)orow)[lane + 64 * j] = w; }
}
__device__ __forceinline__ void phase_prep(const Args& a, LAS unsigned char* lds, int G) {
    int tid_ = threadIdx.x; asm volatile("" : "+v"(tid_)); const int tid = tid_, lane = tid & 63, wave = tid >> 6;
    const int gw = blockIdx.x * 8 + wave, NGW = G * 8;
    unsigned char* ws = a.ws;
    LAS float* scr = (LAS float*)(lds + wave * 16384);
    bf16* wcat = (bf16*)(ws + WS_WCAT);
    constexpr int I_IN = 16 * 80, I_SQ = 16 * 32, I_UP = 16 * 128, I_DN = 64 * 32;
    constexpr int NITEMS = I_IN + 5 * I_SQ + I_UP + I_DN;
    for (int it = gw; it < NITEMS; it += NGW) {
        int r = it;
        if (r < I_IN) { const int kb = r / 80, nb = r % 80, n0 = nb * 32; int drow; float sc = 1.f;
            if (n0 < 512) drow = 256 * (n0 >> 7) + (n0 & 127);
            else if (n0 < 1024) { const int c = n0 - 512; drow = 256 * (c >> 7) + 128 + (c & 127); }
            else { drow = n0; if (n0 < 1280) sc = 0.125f; }
            transpose_item(a.in[8], 2576, D, wcat, kb * 64, n0, drow, nullptr, sc, scr, lane); continue; }
        r -= I_IN;
        if (r < I_SQ) { transpose_item(a.in[20], D, D, wcat, (r / 32) * 64, (r % 32) * 32, NIN + (r % 32) * 32, nullptr, 1.f, scr, lane); continue; } r -= I_SQ;
        if (r < I_SQ) { transpose_item(a.in[21], D, D, wcat, (r / 32) * 64, (r % 32) * 32, NIN + 1024 + (r % 32) * 32, nullptr, 1.f, scr, lane); continue; } r -= I_SQ;
        if (r < I_SQ) { transpose_item(a.in[16], D, D, (bf16*)(ws + WS_WOUT), (r / 32) * 64, (r % 32) * 32, (r % 32) * 32, nullptr, 1.f, scr, lane); continue; } r -= I_SQ;
        if (r < I_SQ) { transpose_item(a.in[19], D, D, (bf16*)(ws + WS_WXQ), (r / 32) * 64, (r % 32) * 32, (r % 32) * 32, a.in[17], 0.0625f, scr, lane); continue; } r -= I_SQ;
        if (r < I_SQ) { transpose_item(a.in[22], D, D, (bf16*)(ws + WS_WXO), (r / 32) * 64, (r % 32) * 32, (r % 32) * 32, nullptr, 1.f, scr, lane); continue; } r -= I_SQ;
        if (r < I_UP) { transpose_item(a.in[24], FF, D, (bf16*)(ws + WS_WUP), (r / 128) * 64, (r % 128) * 32, (r % 128) * 32, a.in[23], 1.f, scr, lane); continue; } r -= I_UP;
        transpose_item(a.in[25], D, FF, (bf16*)(ws + WS_WDN), (r / 32) * 64, (r % 32) * 32, (r % 32) * 32, nullptr, 1.f, scr, lane);
    }
    for (int idx = blockIdx.x * 512 + tid; idx < 256 * 1024; idx += G * 512) {
        const int j = idx >> 10, k = idx & 1023; const float* wr = a.in[8] + (size_t)k * 2576 + 2560; float s = 0.f;
#pragma unroll
        for (int r = 0; r < 16; ++r) s += wr[r] * a.in[9][r * 256 + j];
        wcat[(size_t)(2560 + j) * D + k] = f2bf(s);
    }
    bf16* xn = (bf16*)(ws + WS_XN);
    for (int m = gw; m < NROW + 2048; m += NGW) {
        if (m < NP) norm_row_bf16(a.in[0] + (size_t)m * D, a.in[7], xn + (size_t)m * D, lane);
        else if (m < NROW) norm_row_bf16(a.in[1] + (size_t)(m - NP) * D, a.in[7], xn + (size_t)m * D, lane);
        else norm_row_bf16(a.in[6] + (size_t)(m - NROW) * D, a.in[18], xn + (size_t)(MALL + (m - NROW)) * D, lane);
    }
}

__device__ __forceinline__ void conv_prompt_unit(LAS unsigned char* lds, const Args& a, int unit) {
    int tid_ = threadIdx.x; asm volatile("" : "+v"(tid_)); const int tid = tid_, lane = tid & 63, w = tid >> 6;
    const int b = unit >> 6, t0 = (unit & 63) * 32;
    const bf16* proj = (const bf16*)(a.ws + WS_PROJ); bf16* mix = (bf16*)(a.ws + WS_MIX);
    LAS bf16* in = (LAS bf16*)lds; LAS float* y = (LAS float*)(lds + 65536);
    __syncthreads();
#pragma unroll
    for (int it = 0; it < 8; ++it) { const int row = w + 8 * it; if (row < 62) { const int t = t0 - 30 + row; u32x4 v = {0u, 0u, 0u, 0u};
        if (t >= 0) v = *(const u32x4*)(proj + (size_t)(b * TSEQ + t) * PJ + 8 * lane); *(LAS u32x4*)(in + row * 512 + 8 * lane) = v; } }
    const int c = 64 * w + lane;
    float wgt[31];
#pragma unroll
    for (int k = 0; k < 31; ++k) wgt[k] = a.in[11][k * 512 + c];
    const float bias = a.in[12][c];
    __syncthreads();
    for (int tq = 0; tq < 8; ++tq) {
        float x[34];
#pragma unroll
        for (int k = 0; k < 34; ++k) x[k] = bf2f(in[(4 * tq + k) * 512 + c]);
        float a0 = bias, a1 = bias, a2 = bias, a3 = bias;
#pragma unroll
        for (int k = 0; k < 31; ++k) { a0 += wgt[k] * x[k]; a1 += wgt[k] * x[k + 1]; a2 += wgt[k] * x[k + 2]; a3 += wgt[k] * x[k + 3]; }
        y[(4 * tq + 0) * 512 + c] = a0; y[(4 * tq + 1) * 512 + c] = a1; y[(4 * tq + 2) * 512 + c] = a2; y[(4 * tq + 3) * 512 + c] = a3;
    }
    __syncthreads();
    const f32x4 g0 = *(const f32x4*)(a.in[13] + 8 * lane), g1 = *(const f32x4*)(a.in[13] + 8 * lane + 4), b0 = *(const f32x4*)(a.in[14] + 8 * lane), b1 = *(const f32x4*)(a.in[14] + 8 * lane + 4);
#pragma unroll
    for (int k = 0; k < 4; ++k) {
        const int t = w + 8 * k;
        f32x4 v0 = *(LAS f32x4*)(y + t * 512 + 8 * lane), v1 = *(LAS f32x4*)(y + t * 512 + 8 * lane + 4);
        const float mean = wave_sum((v0[0] + v0[1]) + (v0[2] + v0[3]) + (v1[0] + v1[1]) + (v1[2] + v1[3])) * (1.0f / 512.0f);
        v0 = v0 - mean; v1 = v1 - mean;
        const float var = wave_sum((v0[0] * v0[0] + v0[1] * v0[1]) + (v0[2] * v0[2] + v0[3] * v0[3]) + (v1[0] * v1[0] + v1[1] * v1[1]) + (v1[2] * v1[2] + v1[3] * v1[3])) * (1.0f / 512.0f);
        const float rstd = rsqrtf(var + EPS);
        v0 = v0 * rstd * g0 + b0; v1 = v1 * rstd * g1 + b1;
#pragma unroll
        for (int j = 0; j < 4; ++j) { v0[j] = siluf_(v0[j]); v1[j] = siluf_(v1[j]); }
        *(u32x4*)(mix + (size_t)(b * TSEQ + t0 + t) * D + 8 * lane) = pack8(v0, v1);
    }
}
__device__ __forceinline__ void conv_sample_unit(LAS unsigned char* lds, const Args& a, int b) {
    int tid_ = threadIdx.x; asm volatile("" : "+v"(tid_)); const int tid = tid_, lane = tid & 63, w = tid >> 6, c = tid;
    const bf16* proj = (const bf16*)(a.ws + WS_PROJ); bf16* mix = (bf16*)(a.ws + WS_MIX);
    LAS float* red = (LAS float*)lds;
    float* cs = a.out + O_CS;
    __syncthreads();
    float acc = a.in[12][c];
#pragma unroll 6
    for (int k = 0; k < 30; ++k) { const float v = a.in[2][(size_t)(b * 30 + k) * 512 + c]; acc += a.in[11][k * 512 + c] * v; if (k >= 1) cs[(size_t)(b * 30 + k - 1) * 512 + c] = v; }
    acc += a.in[11][30 * 512 + c] * bf2f(proj[(size_t)(NP + b) * PJ + c]);
    float s = wave_sum(acc); if (lane == 0) red[w] = s;
    __syncthreads();
    float mean = 0.f;
#pragma unroll
    for (int i = 0; i < 8; ++i) mean += red[i];
    mean *= (1.0f / 512.0f);
    const float dv = acc - mean;
    s = wave_sum(dv * dv); if (lane == 0) red[8 + w] = s;
    __syncthreads();
    float var = 0.f;
#pragma unroll
    for (int i = 0; i < 8; ++i) var += red[8 + i];
    const float o = dv * rsqrtf(var * (1.0f / 512.0f) + EPS) * a.in[13][c] + a.in[14][c];
    mix[(size_t)(NP + b) * D + c] = f2bf(siluf_(o));
}
__device__ __forceinline__ void gla1_unit(LAS unsigned char* lds, const Args& a, int unit) {
    int tid_ = threadIdx.x; asm volatile("" : "+v"(tid_)); const int tid = tid_, lane = tid & 63, w = tid >> 6;
    const int bh = unit >> 5, n = unit & 31, b = bh >> 2, h = bh & 3, r0 = b * TSEQ + n * CH;
    const bf16* proj = (const bf16*)(a.ws + WS_PROJ); float* la = (float*)(a.ws + WS_LA); float* kv = (float*)(a.ws + WS_KV); float* dec = (float*)(a.ws + WS_DEC);
    LAS unsigned char* kT = lds; LAS unsigned char* vT = lds + 9216; LAS float* segtot = (LAS float*)(lds + 27648);
    const int d = tid & 63, seg = w;
    __syncthreads();
    float c[8]; float run = 0.f;
#pragma unroll
    for (int j = 0; j < 8; ++j) { run += la[(size_t)(r0 + 8 * seg + j) * 256 + h * 64 + d]; c[j] = run; }
    segtot[seg * 64 + d] = run;
    { const int dv = tid & 127, s4 = tid >> 7; unsigned pk[8];
#pragma unroll
        for (int jj = 0; jj < 8; ++jj) { const unsigned lo = proj[(size_t)(r0 + 16 * s4 + 2 * jj) * PJ + PJ_V + h * 128 + dv], hi = proj[(size_t)(r0 + 16 * s4 + 2 * jj + 1) * PJ + PJ_V + h * 128 + dv]; pk[jj] = lo | (hi << 16); }
        *(LAS u32x4*)(vT + dv * 144 + s4 * 32) = (u32x4){pk[0], pk[1], pk[2], pk[3]}; *(LAS u32x4*)(vT + dv * 144 + s4 * 32 + 16) = (u32x4){pk[4], pk[5], pk[6], pk[7]}; }
    __syncthreads();
    float off = 0.f, tot = 0.f;
#pragma unroll
    for (int s = 0; s < 8; ++s) { const float t = segtot[s * 64 + d]; tot += t; if (s < seg) off += t; }
    float kin[8];
#pragma unroll
    for (int j = 0; j < 8; ++j) { const float bj = c[j] + off; la[(size_t)(r0 + 8 * seg + j) * 256 + h * 64 + d] = bj;
        kin[j] = bf2f(proj[(size_t)(r0 + 8 * seg + j) * PJ + PJ_K + h * 64 + d]) * __expf(tot - bj); }
    *(LAS u32x4*)(kT + d * 144 + seg * 16) = (u32x4){cvt_pk_bf16(kin[0], kin[1]), cvt_pk_bf16(kin[2], kin[3]), cvt_pk_bf16(kin[4], kin[5]), cvt_pk_bf16(kin[6], kin[7])};
    if (seg == 0) dec[(size_t)(bh * NCHUNK + n) * 64 + d] = __expf(tot);
    __syncthreads();
    const int mb = w >> 2, nb = w & 3, nn = lane & 31, g = lane >> 5;
    f32x16 acc;
#pragma unroll
    for (int i = 0; i < 16; ++i) acc[i] = 0.f;
#pragma unroll
    for (int s = 0; s < 4; ++s) { const bf16x8 af = *(LAS bf16x8*)(kT + (32 * mb + nn) * 144 + (16 * s + 8 * g) * 2), bfv = *(LAS bf16x8*)(vT + (32 * nb + nn) * 144 + (16 * s + 8 * g) * 2);
        acc = __builtin_amdgcn_mfma_f32_32x32x16_bf16(af, bfv, acc, 0, 0, 0); }
#pragma unroll
    for (int i = 0; i < 16; ++i) { const int dd = 32 * mb + 8 * (i >> 2) + 4 * g + (i & 3); kv[((size_t)(bh * NCHUNK + n) * 64 + dd) * 128 + 32 * nb + nn] = acc[i]; }
}
__device__ __forceinline__ void gla_sample_unit(LAS unsigned char* lds, const Args& a, int unit) {
    int tid_ = threadIdx.x; asm volatile("" : "+v"(tid_)); const int tid = tid_, lane = tid & 63, w = tid >> 6;
    const int b = unit >> 2, h = unit & 3, row = NP + b;
    const bf16* proj = (const bf16*)(a.ws + WS_PROJ); const float* la = (const float*)(a.ws + WS_LA); bf16* mix = (bf16*)(a.ws + WS_MIX);
    LAS float* red = (LAS float*)lds;
    LAS float* red2 = red + 2048;
    const int dv = 4 * (tid & 31), dg = tid >> 5;
    __syncthreads();
    const u32x2 vv = *(const u32x2*)(proj + (size_t)row * PJ + PJ_V + h * 128 + dv);
    const f32x4 v4 = {bflo(vv.x), bfhi(vv.x), bflo(vv.y), bfhi(vv.y)};
    f32x4 o4 = {0.f, 0.f, 0.f, 0.f};
#pragma unroll
    for (int dd = 0; dd < 4; ++dd) { const int d = 4 * dg + dd;
        const float al = __expf(la[(size_t)row * 256 + h * 64 + d]), kk = bf2f(proj[(size_t)row * PJ + PJ_K + h * 64 + d]), qq = bf2f(proj[(size_t)row * PJ + PJ_Q + h * 64 + d]);
        const size_t so = ((size_t)(b * 4 + h) * 64 + d) * 128 + dv;
        const f32x4 sn = *(const f32x4*)(a.in[3] + so) * al + v4 * kk;
        *(f32x4*)(a.out + O_GS + so) = sn; o4 = o4 + sn * qq; }
    *(LAS f32x4*)(red + dg * 128 + dv) = o4;
    __syncthreads();
    float o = 0.f;
    if (tid < 128) {
#pragma unroll
        for (int i = 0; i < 16; ++i) o += red[i * 128 + tid];
        const float ss = wave_sum(o * o); if (lane == 0) red2[w] = ss;
    }
    __syncthreads();
    if (tid < 128) { const float rstd = rsqrtf((red2[0] + red2[1]) * (1.0f / 128.0f) + EPS);
        mix[(size_t)row * D + 512 + h * 128 + tid] = f2bf(o * rstd * a.in[15][tid] * bf2f(proj[(size_t)row * PJ + PJ_R + h * 128 + tid])); }
}
__device__ __forceinline__ void vt_unit(const Args& a, int unit) {
    int tid_ = threadIdx.x; asm volatile("" : "+v"(tid_)); const int tid = tid_, b = unit >> 2, h = unit & 3, hd = tid & 255, ms = tid >> 8;
    const bf16* mvb = (const bf16*)(a.ws + WS_MVB); bf16* mvt = (bf16*)(a.ws + WS_MVT);
    for (int mc = 0; mc < 16; ++mc) { const int m0 = ms * 128 + mc * 8; unsigned pk[4];
#pragma unroll
        for (int j = 0; j < 4; ++j) { const unsigned lo = mvb[(size_t)(b * 256 + m0 + 2 * j) * D + h * 256 + hd], hi = mvb[(size_t)(b * 256 + m0 + 2 * j + 1) * D + h * 256 + hd]; pk[j] = lo | (hi << 16); }
        *(u32x4*)(mvt + ((size_t)(b * 4 + h) * 256 + hd) * 256 + m0) = (u32x4){pk[0], pk[1], pk[2], pk[3]}; }
}

__device__ __forceinline__ void phase_scan(const Args& a, int G) {
    const float* kv = (const float*)(a.ws + WS_KV); const float* dec = (const float*)(a.ws + WS_DEC); bf16* sb = (bf16*)(a.ws + WS_SB);
    typedef float f32x2 __attribute__((ext_vector_type(2)));
    for (int p = blockIdx.x * 512 + threadIdx.x; p < 32 * 4096; p += G * 512) {
        const int bh = p >> 12, e = (p & 4095) * 2, d = e >> 7;
        f32x2 S = {0.f, 0.f};
#pragma unroll 8
        for (int n = 0; n < NCHUNK; ++n) {
            const size_t o = (size_t)(bh * NCHUNK + n) * 8192 + e;
            const f32x2 k2 = *(const f32x2*)(kv + o); const float dc = dec[(size_t)(bh * NCHUNK + n) * 64 + d];
            *(unsigned*)(sb + o) = cvt_pk_bf16(S[0], S[1]);
            S = S * dc + k2;
        }
        *(f32x2*)(a.out + O_GP + (size_t)bh * 8192 + e) = S;
    }
}

__device__ __forceinline__ void gla3_unit(LAS unsigned char* lds, const Args& a, int unit) {
    int tid_ = threadIdx.x; asm volatile("" : "+v"(tid_)); const int tid = tid_, lane = tid & 63, w = tid >> 6;
    const int bh = unit >> 5, n = unit & 31, b = bh >> 2, h = bh & 3, r0 = b * TSEQ + n * CH;
    const bf16* proj = (const bf16*)(a.ws + WS_PROJ); const float* la = (const float*)(a.ws + WS_LA); const bf16* sb = (const bf16*)(a.ws + WS_SB); bf16* mix = (bf16*)(a.ws + WS_MIX);
    LAS unsigned char* vT = lds; LAS unsigned char* sT = lds + 18432; LAS unsigned char* P = lds + 36864; LAS unsigned char* qin = lds + 46080; LAS unsigned char* kt = lds + 55296;
    LAS float* O = (LAS float*)(lds + 64512);
    __syncthreads();
    { const int d = tid & 63, seg = w;
#pragma unroll
        for (int j = 0; j < 8; ++j) { const int t = 8 * seg + j; const float bb = la[(size_t)(r0 + t) * 256 + h * 64 + d];
            const float q = bf2f(proj[(size_t)(r0 + t) * PJ + PJ_Q + h * 64 + d]), k = bf2f(proj[(size_t)(r0 + t) * PJ + PJ_K + h * 64 + d]);
            *(LAS bf16*)(qin + t * 144 + d * 2) = f2bf(q * __expf(bb)); *(LAS bf16*)(kt + t * 144 + d * 2) = f2bf(k * __expf(-bb)); } }
    { const int dv = tid & 127, s4 = tid >> 7; unsigned pk[8];
#pragma unroll
        for (int jj = 0; jj < 8; ++jj) { const unsigned lo = proj[(size_t)(r0 + 16 * s4 + 2 * jj) * PJ + PJ_V + h * 128 + dv], hi = proj[(size_t)(r0 + 16 * s4 + 2 * jj + 1) * PJ + PJ_V + h * 128 + dv]; pk[jj] = lo | (hi << 16); }
        *(LAS u32x4*)(vT + dv * 144 + s4 * 32) = (u32x4){pk[0], pk[1], pk[2], pk[3]}; *(LAS u32x4*)(vT + dv * 144 + s4 * 32 + 16) = (u32x4){pk[4], pk[5], pk[6], pk[7]};
        const bf16* sp = sb + (size_t)(bh * NCHUNK + n) * 8192;
#pragma unroll
        for (int jj = 0; jj < 8; ++jj) { const unsigned lo = sp[(16 * s4 + 2 * jj) * 128 + dv], hi = sp[(16 * s4 + 2 * jj + 1) * 128 + dv]; pk[jj] = lo | (hi << 16); }
        *(LAS u32x4*)(sT + dv * 144 + s4 * 32) = (u32x4){pk[0], pk[1], pk[2], pk[3]}; *(LAS u32x4*)(sT + dv * 144 + s4 * 32 + 16) = (u32x4){pk[4], pk[5], pk[6], pk[7]}; }
    __syncthreads();
    const int nn = lane & 31, g = lane >> 5;
    if (w < 4) { const int ib = w >> 1, jb = w & 1;
        f32x16 acc;
#pragma unroll
        for (int i = 0; i < 16; ++i) acc[i] = 0.f;
#pragma unroll
        for (int s = 0; s < 4; ++s) { const bf16x8 af = *(LAS bf16x8*)(qin + (32 * ib + nn) * 144 + (16 * s + 8 * g) * 2), bfv = *(LAS bf16x8*)(kt + (32 * jb + nn) * 144 + (16 * s + 8 * g) * 2);
            acc = __builtin_amdgcn_mfma_f32_32x32x16_bf16(af, bfv, acc, 0, 0, 0); }
#pragma unroll
        for (int i = 0; i < 16; ++i) { const int ii = 32 * ib + 8 * (i >> 2) + 4 * g + (i & 3), jj = 32 * jb + nn; *(LAS bf16*)(P + ii * 144 + jj * 2) = f2bf(jj <= ii ? acc[i] : 0.f); } }
    __syncthreads();
    { const int ib = w >> 2, nb = w & 3;
        f32x16 acc;
#pragma unroll
        for (int i = 0; i < 16; ++i) acc[i] = 0.f;
#pragma unroll
        for (int s = 0; s < 4; ++s) { const bf16x8 af = *(LAS bf16x8*)(P + (32 * ib + nn) * 144 + (16 * s + 8 * g) * 2), bfv = *(LAS bf16x8*)(vT + (32 * nb + nn) * 144 + (16 * s + 8 * g) * 2);
            acc = __builtin_amdgcn_mfma_f32_32x32x16_bf16(af, bfv, acc, 0, 0, 0); }
#pragma unroll
        for (int s = 0; s < 4; ++s) { const bf16x8 af = *(LAS bf16x8*)(qin + (32 * ib + nn) * 144 + (16 * s + 8 * g) * 2), bfv = *(LAS bf16x8*)(sT + (32 * nb + nn) * 144 + (16 * s + 8 * g) * 2);
            acc = __builtin_amdgcn_mfma_f32_32x32x16_bf16(af, bfv, acc, 0, 0, 0); }
#pragma unroll
        for (int i = 0; i < 16; ++i) { const int ii = 32 * ib + 8 * (i >> 2) + 4 * g + (i & 3); O[ii * 132 + 32 * nb + nn] = acc[i]; } }
    __syncthreads();
    { const int i = tid >> 3, part = tid & 7; f32x4 o[4]; float ss = 0.f;
#pragma unroll
        for (int j = 0; j < 4; ++j) { o[j] = *(LAS f32x4*)(O + i * 132 + 16 * part + 4 * j); ss += (o[j][0] * o[j][0] + o[j][1] * o[j][1]) + (o[j][2] * o[j][2] + o[j][3] * o[j][3]); }
        ss += __shfl_xor(ss, 1); ss += __shfl_xor(ss, 2); ss += __shfl_xor(ss, 4);
        const float rstd = rsqrtf(ss * (1.0f / 128.0f) + EPS);
        const size_t row = (size_t)(r0 + i);
        const u32x4 r0v = *(const u32x4*)(proj + row * PJ + PJ_R + h * 128 + 16 * part), r1v = *(const u32x4*)(proj + row * PJ + PJ_R + h * 128 + 16 * part + 8);
        const float* gg = a.in[15] + 16 * part;
        const unsigned rw[8] = {r0v.x, r0v.y, r0v.z, r0v.w, r1v.x, r1v.y, r1v.z, r1v.w};
        unsigned ow[8];
#pragma unroll
        for (int j = 0; j < 8; ++j) { const float x0 = o[j >> 1][(j & 1) * 2] * rstd * gg[2 * j] * bflo(rw[j]), x1 = o[j >> 1][(j & 1) * 2 + 1] * rstd * gg[2 * j + 1] * bfhi(rw[j]); ow[j] = cvt_pk_bf16(x0, x1); }
        bf16* op = mix + row * D + 512 + h * 128 + 16 * part;
        *(u32x4*)op = (u32x4){ow[0], ow[1], ow[2], ow[3]}; *(u32x4*)(op + 8) = (u32x4){ow[4], ow[5], ow[6], ow[7]}; }
}

__device__ __forceinline__ void attn_prompt_unit(LAS unsigned char* lds, const Args& a, int unit) {
    int tid_ = threadIdx.x; asm volatile("" : "+v"(tid_)); const int tid = tid_, lane = tid & 63, w = tid >> 6, nn = lane & 31, g = lane >> 5;
    const int b = unit >> 5, h = (unit >> 3) & 3, qt = unit & 7;
    const bf16* qx = (const bf16*)(a.ws + WS_QX); const bf16* mkb = (const bf16*)(a.ws + WS_MKB); const bf16* mvt = (const bf16*)(a.ws + WS_MVT); bf16* ao = (bf16*)(a.ws + WS_AO);
    const size_t qrow = (size_t)b * TSEQ + qt * 256 + 32 * w + nn;
    __syncthreads();
#pragma unroll 4
    for (int it = 0; it < 16; ++it) { const int row = (tid >> 5) + 16 * it, ch = tid & 31;
        *(LAS u32x4*)(lds + row * 528 + ch * 16) = *(const u32x4*)(mkb + (size_t)(b * 256 + row) * D + h * 256 + ch * 8); }
    bf16x8 qf[16];
#pragma unroll
    for (int s = 0; s < 16; ++s) qf[s] = *(const bf16x8*)(qx + qrow * D + h * 256 + 16 * s + 8 * g);
    __syncthreads();
    f32x16 acc[8];
#pragma unroll
    for (int kb = 0; kb < 8; ++kb) {
#pragma unroll
        for (int i = 0; i < 16; ++i) acc[kb][i] = 0.f;
#pragma unroll
        for (int s = 0; s < 16; ++s) { const bf16x8 af = *(LAS bf16x8*)(lds + (32 * kb + nn) * 528 + (16 * s + 8 * g) * 2); acc[kb] = __builtin_amdgcn_mfma_f32_32x32x16_bf16(af, qf[s], acc[kb], 0, 0, 0); }
    }
    float mx = -3.0e38f;
#pragma unroll
    for (int kb = 0; kb < 8; ++kb)
#pragma unroll
        for (int i = 0; i < 16; ++i) mx = fmaxf(mx, acc[kb][i]);
    mx = fmaxf(mx, __shfl_xor(mx, 32));
    float sum = 0.f;
    u32x4 pb[8][2];
#pragma unroll
    for (int kb = 0; kb < 8; ++kb) {
#pragma unroll
        for (int i = 0; i < 16; ++i) { const float p = __expf(acc[kb][i] - mx); sum += p; acc[kb][i] = p; }
#pragma unroll
        for (int hh = 0; hh < 2; ++hh) { pb[kb][hh].x = cvt_pk_bf16(acc[kb][8 * hh + 0], acc[kb][8 * hh + 1]); pb[kb][hh].y = cvt_pk_bf16(acc[kb][8 * hh + 2], acc[kb][8 * hh + 3]);
            pb[kb][hh].z = cvt_pk_bf16(acc[kb][8 * hh + 4], acc[kb][8 * hh + 5]); pb[kb][hh].w = cvt_pk_bf16(acc[kb][8 * hh + 6], acc[kb][8 * hh + 7]); }
    }
    sum += __shfl_xor(sum, 32);
    const float inv = 1.0f / sum;
    __syncthreads();
#pragma unroll 4
    for (int it = 0; it < 16; ++it) { const int row = (tid >> 5) + 16 * it, ch = tid & 31;
        *(LAS u32x4*)(lds + row * 528 + ch * 16) = *(const u32x4*)(mvt + ((size_t)(b * 4 + h) * 256 + row) * 256 + ch * 8); }
    __syncthreads();
#pragma unroll
    for (int mb = 0; mb < 8; ++mb) {
        f32x16 o;
#pragma unroll
        for (int i = 0; i < 16; ++i) o[i] = 0.f;
#pragma unroll
        for (int kb = 0; kb < 8; ++kb)
#pragma unroll
            for (int hh = 0; hh < 2; ++hh) { const int base = 32 * kb + 16 * hh;
                const u32x2 lo = *(LAS u32x2*)(lds + (32 * mb + nn) * 528 + (base + 4 * g) * 2), hi = *(LAS u32x2*)(lds + (32 * mb + nn) * 528 + (base + 8 + 4 * g) * 2);
                const u32x4 av = {lo.x, lo.y, hi.x, hi.y};
                o = __builtin_amdgcn_mfma_f32_32x32x16_bf16(__builtin_bit_cast(bf16x8, av), __builtin_bit_cast(bf16x8, pb[kb][hh]), o, 0, 0, 0); }
#pragma unroll
        for (int i4 = 0; i4 < 4; ++i4) { u32x2 wv; wv.x = cvt_pk_bf16(o[4 * i4] * inv, o[4 * i4 + 1] * inv); wv.y = cvt_pk_bf16(o[4 * i4 + 2] * inv, o[4 * i4 + 3] * inv);
            *(u32x2*)(ao + qrow * D + h * 256 + 32 * mb + 8 * i4 + 4 * g) = wv; }
    }
}
__device__ __forceinline__ void attn_sample_unit(LAS unsigned char* lds, const Args& a, int unit) {
    int tid_ = threadIdx.x; asm volatile("" : "+v"(tid_)); const int tid = tid_, lane = tid & 63, w = tid >> 6;
    const int b = unit >> 2, h = unit & 3;
    const bf16* qx = (const bf16*)(a.ws + WS_QX); bf16* ao = (bf16*)(a.ws + WS_AO);
    LAS float* sc = (LAS float*)lds; LAS float* red = sc + 256;
    const u32x2 qq = *(const u32x2*)(qx + (size_t)(NP + b) * D + h * 256 + 4 * lane);
    const f32x4 q4 = {bflo(qq.x), bfhi(qq.x), bflo(qq.y), bfhi(qq.y)};
    const float* kbase = a.in[4] + ((size_t)b * 256 * 4 + h) * 256 + 4 * lane;
    const float* vbase = a.in[5] + ((size_t)b * 256 * 4 + h) * 256 + 4 * lane;
    __syncthreads();
#pragma unroll 1
    for (int c = 0; c < 4; ++c) {
        f32x4 kv[8];
#pragma unroll
        for (int j = 0; j < 8; ++j) kv[j] = *(const f32x4*)(kbase + (size_t)(32 * w + 8 * c + j) * 1024);
#pragma unroll
        for (int j = 0; j < 8; ++j) { const float dsum = wave_sum((kv[j][0] * q4[0] + kv[j][1] * q4[1]) + (kv[j][2] * q4[2] + kv[j][3] * q4[3])); if (lane == j) sc[32 * w + 8 * c + j] = dsum; }
    }
    __syncthreads();
    const float s0 = sc[lane], s1 = sc[64 + lane], s2 = sc[128 + lane], s3 = sc[192 + lane];
    const float mx = wave_max(fmaxf(fmaxf(s0, s1), fmaxf(s2, s3)));
    const float inv = 1.0f / wave_sum((__expf(s0 - mx) + __expf(s1 - mx)) + (__expf(s2 - mx) + __expf(s3 - mx)));
    f32x4 o4 = {0.f, 0.f, 0.f, 0.f};
#pragma unroll 1
    for (int c = 0; c < 4; ++c) {
        f32x4 vv[8];
#pragma unroll
        for (int j = 0; j < 8; ++j) vv[j] = *(const f32x4*)(vbase + (size_t)(32 * w + 8 * c + j) * 1024);
#pragma unroll
        for (int j = 0; j < 8; ++j) { const float p = __expf(sc[32 * w + 8 * c + j] - mx) * inv; o4 = o4 + vv[j] * p; }
    }
    *(LAS f32x4*)(red + w * 256 + 4 * lane) = o4;
    __syncthreads();
    if (tid < 256) { float o = 0.f;
#pragma unroll
        for (int i = 0; i < 8; ++i) o += red[i * 256 + tid];
        ao[(size_t)(NP + b) * D + h * 256 + tid] = f2bf(o); }
}

__device__ __forceinline__ void phase_final(const Args& a, int G) {
    int tid_ = threadIdx.x; asm volatile("" : "+v"(tid_)); const int tid = tid_, lane = tid & 63, wave = tid >> 6;
    const float* part = (const float*)(a.ws + WS_PART + 2 * PART_BYTES);
    for (int m = blockIdx.x * 8 + wave; m < NROW; m += G * 8) {
        float* y = a.out + (m < NP ? O_YP + (size_t)m * D : O_YS + (size_t)(m - NP) * D);
        const float pv = lane < 16 ? part[(size_t)m * 16 + lane] : 0.f;
        const float rstd = rsqrtf(wave_sum(pv) * (1.0f / D) + EPS);
#pragma unroll
        for (int j = 0; j < 4; ++j) { const f32x4 gv = ((const f32x4*)a.in[26])[lane + 64 * j]; f32x4 v = ((f32x4*)y)[lane + 64 * j]; ((f32x4*)y)[lane + 64 * j] = v * rstd * gv; }
    }
}

__global__ void __launch_bounds__(512, 2) hybrid_fwd(Args a) {
    extern __shared__ __attribute__((aligned(16))) unsigned char lds_raw[];
    LAS unsigned char* lds = (LAS unsigned char*)lds_raw;
    cg::grid_group grid = cg::this_grid();
    const int G = gridDim.x, bx = blockIdx.x;
    unsigned char* ws = a.ws;
    const int lo = a.ph_lo, hi = a.ph_hi;
#define IN(k) (lo <= (k) && (k) < hi)
#define SEAM(k) do { if (IN(k) && IN((k) + 1)) grid.sync(); } while (0)

    if (IN(0)) phase_prep(a, lds, G);
    SEAM(0);
    if (IN(1)) {
        __syncthreads();
        pg8::Gemm g{(const bf16*)(ws + WS_XN), (const bf16*)(ws + WS_WCAT), 0, 0, D}; OrderRect S; S.init(65, 11, G, bx, 8, 8, 65, 11);
        EpiG1 E{(bf16*)(ws + WS_PROJ), (float*)(ws + WS_LA), a.in[10], a.out + O_CP, a.out + O_CS, a.out + O_MK, a.out + O_MV, (bf16*)(ws + WS_MKB), (bf16*)(ws + WS_MVB)};
        pg8::gemm_phase<EpiG1, OrderRect, true, true>(lds, g, S, E);
    }
    SEAM(1);
    if (IN(2)) {
        constexpr int U_CONV = 512, U_G1 = 1024, U_CS = 128, U_GS = 512, U_VT = 32, U_ALL = U_CONV + U_G1 + U_CS + U_GS + U_VT;
        for (int u = bx; u < U_ALL; u += G) {
            int r = u;
            if (r < U_G1) { gla1_unit(lds, a, r); continue; } r -= U_G1;
            if (r < U_CONV) { conv_prompt_unit(lds, a, r); continue; } r -= U_CONV;
            if (r < U_GS) { gla_sample_unit(lds, a, r); continue; } r -= U_GS;
            if (r < U_CS) { conv_sample_unit(lds, a, r); continue; } r -= U_CS;
            vt_unit(a, r);
        }
    }
    SEAM(2);
    if (IN(3)) phase_scan(a, G);
    SEAM(3);
    if (IN(4)) { for (int u = bx; u < 1024; u += G) gla3_unit(lds, a, u); }
    SEAM(4);
    if (IN(5)) {
        __syncthreads();
        pg8::Gemm g{(const bf16*)(ws + WS_MIX), (const bf16*)(ws + WS_WOUT), 0, 0, D}; OrderRect S; S.init(65, 4, G, bx);
        EpiRes E{a.in[0], a.in[1], (float*)(ws + WS_X1), (float*)(ws + WS_X1) + (size_t)NP * D, (bf16*)(ws + WS_XB), (float*)(ws + WS_PART)};
        pg8::gemm_phase<EpiRes, OrderRect, true, true>(lds, g, S, E);
    }
    SEAM(5);
    if (IN(6)) {
        __syncthreads();
        pg8::Gemm g{(const bf16*)(ws + WS_XB), (const bf16*)(ws + WS_WXQ), 0, 0, D}; OrderRect S; S.init(65, 4, G, bx);
        EpiScale<0> E{(const float*)(ws + WS_PART), (bf16*)(ws + WS_QX), D};
        pg8::gemm_phase<EpiScale<0>, OrderRect, true, true>(lds, g, S, E);
    }
    SEAM(6);
    if (IN(7)) {
        for (int u = bx; u < 256 + 512; u += G) { if (u < 256) attn_prompt_unit(lds, a, u); else attn_sample_unit(lds, a, u - 256); }
    }
    SEAM(7);
    if (IN(8)) {
        __syncthreads();
        pg8::Gemm g{(const bf16*)(ws + WS_AO), (const bf16*)(ws + WS_WXO), 0, 0, D}; OrderRect S; S.init(65, 4, G, bx);
        float* x1 = (float*)(ws + WS_X1);
        EpiRes E{x1, x1 + (size_t)NP * D, x1, x1 + (size_t)NP * D, (bf16*)(ws + WS_XB), (float*)(ws + WS_PART + PART_BYTES)};
        pg8::gemm_phase<EpiRes, OrderRect, true, true>(lds, g, S, E);
    }
    SEAM(8);
    if (IN(9)) {
        __syncthreads();
        pg8::Gemm g{(const bf16*)(ws + WS_XB), (const bf16*)(ws + WS_WUP), 0, 0, D}; OrderRect S; S.init(65, 16, G, bx);
        EpiScale<1> E{(const float*)(ws + WS_PART + PART_BYTES), (bf16*)(ws + WS_HB), FF};
        pg8::gemm_phase<EpiScale<1>, OrderRect, true, true>(lds, g, S, E);
    }
    SEAM(9);
    if (IN(10)) {
        __syncthreads();
        pg8::Gemm g{(const bf16*)(ws + WS_HB), (const bf16*)(ws + WS_WDN), 0, 0, FF}; OrderRect S; S.init(65, 4, G, bx);
        float* x1 = (float*)(ws + WS_X1);
        EpiRes E{x1, x1 + (size_t)NP * D, a.out + O_YP, a.out + O_YS, nullptr, (float*)(ws + WS_PART + 2 * PART_BYTES)};
        pg8::gemm_phase<EpiRes, OrderRect, true, true>(lds, g, S, E);
    }
    SEAM(10);
    if (IN(11)) phase_final(a, G);
#undef IN
#undef SEAM
}

#ifndef N_LAUNCHES
#define N_LAUNCHES 1
#endif
extern "C" void kernel_launch(void* const* d_in, const int* in_sizes, int n_in, void* d_out, int out_size, void* d_ws, size_t ws_size, hipStream_t stream) {
    static int grid = 0;
    if (grid == 0) {
        if (n_in != 27 || ws_size < WS_END) { fprintf(stderr, "kernel_launch: unexpected n_in %d / ws %zu\n", n_in, ws_size); grid = -1; return; }
        int dev = 0, cus = 0, per_cu = 0;
        hipGetDevice(&dev); hipDeviceGetAttribute(&cus, hipDeviceAttributeMultiprocessorCount, dev);
        if (hipFuncSetAttribute((const void*)hybrid_fwd, hipFuncAttributeMaxDynamicSharedMemorySize, LDS_BYTES) != hipSuccess) { fprintf(stderr, "kernel_launch: hipFuncSetAttribute failed\n"); grid = -1; return; }
        if (hipOccupancyMaxActiveBlocksPerMultiprocessor(&per_cu, (const void*)hybrid_fwd, 512, LDS_BYTES) != hipSuccess || per_cu < 1) { fprintf(stderr, "kernel_launch: occupancy query says %d\n", per_cu); per_cu = 1; }
        (void)hipGetLastError();
        grid = cus * 1;
        fprintf(stderr, "kernel_launch: grid %d (cus %d, per_cu %d)\n", grid, cus, per_cu);
    }
    if (grid < 0) return;
    Args a{};
    for (int i = 0; i < 27; ++i) a.in[i] = (const float*)d_in[i];
    a.out = (float*)d_out; a.ws = (unsigned char*)d_ws;
    if (N_LAUNCHES == 1) {
        a.ph_lo = 0; a.ph_hi = 12;
        void* args[] = {&a};
        hipError_t e = hipLaunchCooperativeKernel((const void*)hybrid_fwd, dim3(grid), dim3(512), args, LDS_BYTES, stream);
        if (e != hipSuccess) fprintf(stderr, "cooperative launch failed: %s (grid %d)\n", hipGetErrorString(e), grid);
    } else {
        for (int p = 0; p < 12; ++p) { a.ph_lo = p; a.ph_hi = p + 1; hipLaunchKernelGGL(hybrid_fwd, dim3(grid), dim3(512), LDS_BYTES, stream, a); }
    }
}
```

```cpp
#include <hip/hip_runtime.h>
#include <hip/hip_cooperative_groups.h>
#include <cstdio>
#include <cstdint>
namespace cg = cooperative_groups;
namespace pg8 {
#define PG8_LAS __attribute__((address_space(3)))
typedef unsigned short bf16_t;
typedef short bf16x8 __attribute__((ext_vector_type(8)));
typedef float f32x4 __attribute__((ext_vector_type(4)));
typedef unsigned u32x4 __attribute__((ext_vector_type(4)));
constexpr int BM = 256, BK = 64, HALF = 128, HTB = HALF * BK * 2  , STAGE_BYTES = 8 * HTB, NXCD = 8, WGM = 8;

__host__ __device__ __forceinline__ int lds_byte(int r, int c) { const int st = (r >> 4) * 2 + (c >> 5), rr = r & 15, cc = c & 31, ob = rr * 64 + cc * 2; return st * 1024 + (ob ^ (((ob >> 9) & 1) << 5)); }
__host__ __device__ __forceinline__ void stage_rc(int b, int& R, int& C) { const int st = b / 1024, sb = b % 1024, swz = sb ^ (((sb >> 9) & 1) << 5); R = (st >> 1) * 16 + swz / 64; C = (st & 1) * 32 + (swz % 64) / 2; }
__host__ __device__ __forceinline__ int perm32(int rho) { const int n = rho >> 4, i = rho & 15; return 8 * (i >> 2) + 4 * n + (i & 3); }

struct Unit { int pm, pn; };
struct Gemm { const bf16_t* A; const bf16_t* Bt; int M, N, K; };
__device__ __forceinline__ unsigned cvt_pk_bf16(float lo, float hi) { unsigned r; asm volatile("v_cvt_pk_bf16_f32 %0, %1, %2" : "=v"(r) : "v"(lo), "v"(hi)); return r; }
template <class Epi, class Sched, bool ALIGN_EPI = false, bool SP2 = false>
__device__ __forceinline__ void gemm_phase(PG8_LAS unsigned char* lds, const Gemm g, const Sched& S, const Epi& E) {
    const int tid = threadIdx.x, wid = __builtin_amdgcn_readfirstlane(tid >> 6), lane = tid & 63, wr = wid >> 2, wc = wid & 3, fr = lane & 15, fq = lane >> 4;
    const int K = g.K, nt = K / BK;
    unsigned voffA[2], voffB[2];
#pragma unroll
    for (int i = 0; i < 2; ++i) { int R, C; stage_rc(tid * 16 + i * 8192, R, C); const int Rb = Epi::PERM ? ((R & ~31) + perm32(R & 31)) : R;
        voffA[i] = (unsigned)(R * K + C) * 2u; voffB[i] = (unsigned)(Rb * K + C) * 2u; }
    const size_t kstep = (size_t)(BK * 2);
    const size_t hstep = (size_t)HALF * K * 2;
    const size_t tstep = 2 * hstep;
    const unsigned ldsw = (unsigned)wid * 1024u;
    const int aoff = lds_byte(wr * 64 + fr, fq * 8), boff = lds_byte(wc * 32 + fr, fq * 8);
#define PG8_SA(b, h) (((b) * 2 + (h)) * HTB)
#define PG8_SB(b, h) ((4 + (b) * 2 + (h)) * HTB)
#define PG8_STAGE(bufoff, gbase, voff) do { _Pragma("unroll") for (int _i = 0; _i < 2; ++_i) \
        __builtin_amdgcn_global_load_lds((const unsigned*)((const char*)(gbase) + (voff)[_i]), (PG8_LAS unsigned*)(lds + (bufoff) + ldsw + _i * 8192), 16, 0, 0); } while (0)
#define PG8_LDA(dst, b, h) do { _Pragma("unroll") for (int m = 0; m < 4; ++m) _Pragma("unroll") for (int k = 0; k < 2; ++k) dst[m][k] = *(const PG8_LAS bf16x8*)(lds + PG8_SA(b, h) + aoff + m * 2048 + k * 1024); } while (0)
#define PG8_LDB(dst, b, h) do { _Pragma("unroll") for (int n = 0; n < 2; ++n) _Pragma("unroll") for (int k = 0; k < 2; ++k) dst[n][k] = *(const PG8_LAS bf16x8*)(lds + PG8_SB(b, h) + boff + n * 2048 + k * 1024); } while (0)
#define PG8_MMA(ai, bj, At, Bt) do { __builtin_amdgcn_s_setprio(1); _Pragma("unroll") for (int m = 0; m < 4; ++m) _Pragma("unroll") for (int n = 0; n < 2; ++n) _Pragma("unroll") for (int k = 0; k < 2; ++k) \
        acc[ai][bj][m][n] = __builtin_amdgcn_mfma_f32_16x16x32_bf16(Bt[n][k], At[m][k], acc[ai][bj][m][n], 0, 0, 0); __builtin_amdgcn_s_setprio(0); } while (0)
#define PG8_WAIT_V(n) asm volatile("s_waitcnt vmcnt(" #n ")" ::: "memory")
#define PG8_WAIT_L(n) asm volatile("s_waitcnt lgkmcnt(" #n ")" ::: "memory")
#define PG8_BAR __builtin_amdgcn_s_barrier()
#define PG8_SCHED __builtin_amdgcn_sched_barrier(0)
    Unit cur, nxt; int ui = 0;
    if (!S.next(0, cur)) return;
    f32x4 acc[2][2][4][2];
#pragma unroll
    for (int a = 0; a < 2; ++a)
#pragma unroll
        for (int b = 0; b < 2; ++b)
#pragma unroll
            for (int m = 0; m < 4; ++m)
#pragma unroll
                for (int n = 0; n < 2; ++n) acc[a][b][m][n] = (f32x4){0.f, 0.f, 0.f, 0.f};
    bf16x8 At[4][2], B0[2][2], B1[2][2];
    const char* cA = (const char*)g.A + (size_t)cur.pm * tstep; const char* cB = (const char*)g.Bt + (size_t)cur.pn * tstep;
    S.a_ready(cur);
    if constexpr (SP2) {
        PG8_STAGE(PG8_SB(0, 0), cB, voffB); PG8_STAGE(PG8_SB(0, 1), cB + hstep, voffB); PG8_STAGE(PG8_SA(0, 0), cA, voffA); PG8_STAGE(PG8_SA(0, 1), cA + hstep, voffA);
        if (wr == 1) PG8_BAR;
        PG8_WAIT_V(2); PG8_BAR;
        PG8_STAGE(PG8_SB(1, 0), cB + kstep, voffB); PG8_STAGE(PG8_SA(1, 0), cA + kstep, voffA); PG8_STAGE(PG8_SB(1, 1), cB + hstep + kstep, voffB);
        PG8_WAIT_V(6); PG8_BAR;
    } else {
        PG8_STAGE(PG8_SB(0, 0), cB, voffB); PG8_STAGE(PG8_SA(0, 0), cA, voffA); PG8_STAGE(PG8_SB(0, 1), cB + hstep, voffB); PG8_STAGE(PG8_SA(0, 1), cA + hstep, voffA);
        if (wr == 1) PG8_BAR;
        PG8_WAIT_V(4); PG8_BAR;
        PG8_STAGE(PG8_SB(1, 0), cB + kstep, voffB); PG8_STAGE(PG8_SA(1, 0), cA + kstep, voffA); PG8_STAGE(PG8_SB(1, 1), cB + hstep + kstep, voffB);
        PG8_WAIT_V(6); PG8_BAR;
    }
    for (;;) {
        const bool has_next = S.next(ui + 1, nxt);
        const char* nA = has_next ? (const char*)g.A + (size_t)nxt.pm * tstep : cA; const char* nB = has_next ? (const char*)g.Bt + (size_t)nxt.pn * tstep : cB;
        for (int t = 0; t < nt; t += 2) {
            const bool last = (t == nt - 2);
            const char* a1 = cA + (size_t)(t + 1) * kstep;
            const char* a2 = last ? nA : cA + (size_t)(t + 2) * kstep; const char* b2 = last ? nB : cB + (size_t)(t + 2) * kstep;
            const char* a3 = a2 + kstep; const char* b3 = b2 + kstep;
            if (last && has_next) S.a_ready(nxt);
            if constexpr (SP2) {
            PG8_LDB(B0, 0, 0); PG8_LDB(B1, 0, 1); PG8_SCHED; PG8_LDA(At, 0, 0); PG8_STAGE(PG8_SA(1, 1), a1 + hstep, voffA);
            PG8_WAIT_V(8); PG8_WAIT_L(0); PG8_BAR; PG8_MMA(0, 0, At, B0); PG8_MMA(0, 1, At, B1); PG8_BAR; PG8_SCHED;
            PG8_LDA(At, 0, 1); PG8_STAGE(PG8_SB(0, 0), b2, voffB); PG8_STAGE(PG8_SB(0, 1), b2 + hstep, voffB); PG8_STAGE(PG8_SA(0, 0), a2, voffA);
            PG8_WAIT_V(8); PG8_WAIT_L(0); PG8_BAR; PG8_MMA(1, 0, At, B0); PG8_MMA(1, 1, At, B1); PG8_BAR; PG8_SCHED;
            PG8_LDB(B0, 1, 0); PG8_LDB(B1, 1, 1); PG8_SCHED; PG8_LDA(At, 1, 0); PG8_STAGE(PG8_SA(0, 1), a2 + hstep, voffA);
            PG8_WAIT_V(8); PG8_WAIT_L(0); PG8_BAR; PG8_MMA(0, 0, At, B0); PG8_MMA(0, 1, At, B1); PG8_BAR; PG8_SCHED;
            PG8_LDA(At, 1, 1); PG8_STAGE(PG8_SB(1, 0), b3, voffB); PG8_STAGE(PG8_SB(1, 1), b3 + hstep, voffB); PG8_STAGE(PG8_SA(1, 0), a3, voffA);
            PG8_WAIT_V(8); PG8_WAIT_L(0); PG8_BAR; PG8_MMA(1, 0, At, B0); PG8_MMA(1, 1, At, B1); PG8_BAR; PG8_SCHED;
            } else {
            PG8_LDB(B0, 0, 0); PG8_SCHED; PG8_LDA(At, 0, 0); PG8_STAGE(PG8_SA(1, 1), a1 + hstep, voffA);
            PG8_WAIT_L(8); PG8_BAR; PG8_WAIT_L(0); PG8_MMA(0, 0, At, B0); PG8_BAR; PG8_SCHED;
            PG8_LDB(B1, 0, 1); PG8_STAGE(PG8_SB(0, 0), b2, voffB);
            PG8_BAR; PG8_WAIT_L(0); PG8_MMA(0, 1, At, B1); PG8_BAR;
            PG8_LDA(At, 0, 1); PG8_STAGE(PG8_SA(0, 0), a2, voffA);
            PG8_BAR; PG8_WAIT_L(0); PG8_MMA(1, 0, At, B0); PG8_BAR; PG8_SCHED;
            PG8_STAGE(PG8_SB(0, 1), b2 + hstep, voffB);
            PG8_WAIT_V(6); PG8_BAR; PG8_MMA(1, 1, At, B1); PG8_BAR;
            PG8_LDB(B0, 1, 0); PG8_SCHED; PG8_LDA(At, 1, 0); PG8_STAGE(PG8_SA(0, 1), a2 + hstep, voffA);
            PG8_WAIT_L(8); PG8_BAR; PG8_WAIT_L(0); PG8_MMA(0, 0, At, B0); PG8_BAR; PG8_SCHED;
            PG8_LDB(B1, 1, 1); PG8_STAGE(PG8_SB(1, 0), b3, voffB);
            PG8_BAR; PG8_WAIT_L(0); PG8_MMA(0, 1, At, B1); PG8_BAR;
            PG8_LDA(At, 1, 1); PG8_STAGE(PG8_SA(1, 0), a3, voffA);
            PG8_BAR; PG8_WAIT_L(0); PG8_MMA(1, 0, At, B0); PG8_BAR; PG8_SCHED;
            PG8_STAGE(PG8_SB(1, 1), b3 + hstep, voffB);
            PG8_WAIT_V(6); PG8_BAR; PG8_MMA(1, 1, At, B1); PG8_BAR;
            }
        }
        if constexpr (ALIGN_EPI) { if (wr == 0) PG8_BAR; }
        if constexpr (!Epi::AFTER_DRAIN) { E(acc, cur, wr, wc, fr, fq); S.done(cur); }
        if (!has_next) break;
#pragma unroll
        for (int a = 0; a < 2; ++a)
#pragma unroll
            for (int b = 0; b < 2; ++b)
#pragma unroll
                for (int m = 0; m < 4; ++m)
#pragma unroll
                    for (int n = 0; n < 2; ++n) acc[a][b][m][n] = (f32x4){0.f, 0.f, 0.f, 0.f};
        cur = nxt; cA = nA; cB = nB; ++ui;
        if constexpr (ALIGN_EPI) { if (wr == 1) PG8_BAR; }
    }
    PG8_WAIT_V(0);
    if constexpr (!ALIGN_EPI) { if (wr == 0) PG8_BAR; }
    PG8_BAR;
    if constexpr (Epi::AFTER_DRAIN) { E.fused(acc, cur, wr, wc, fr, fq, lds, wid, lane); S.done(cur); }
#undef PG8_SA
#undef PG8_SB
#undef PG8_STAGE
#undef PG8_LDA
#undef PG8_LDB
#undef PG8_MMA
#undef PG8_WAIT_V
#undef PG8_WAIT_L
#undef PG8_BAR
#undef PG8_SCHED
}
}

#define LAS __attribute__((address_space(3)))
typedef unsigned short bf16;
typedef pg8::bf16x8 bf16x8;
typedef pg8::f32x4 f32x4;
typedef pg8::u32x4 u32x4;
typedef float f32x16 __attribute__((ext_vector_type(16)));
typedef unsigned u32x2 __attribute__((ext_vector_type(2)));
using pg8::cvt_pk_bf16;

constexpr int NP = 16384, NS = 128, NROW = NP + NS, MALL = 16640, D = 1024, FF = 4096, TSEQ = 2048;
constexpr int NIN = 2816;
constexpr int PJ = 2048;
constexpr int PJ_Q = 512, PJ_K = 768, PJ_V = 1024, PJ_R = 1536;
constexpr float EPS = 1e-6f;
constexpr int NCHUNK = 32, CH = 64;

constexpr size_t MiB = 1u << 20;
constexpr size_t WS_PART = 1 * MiB;
constexpr size_t PART_BYTES = (size_t)MALL * 16 * 4;
constexpr size_t WS_DEC = 5 * MiB;
constexpr size_t WS_WCAT = 6 * MiB;
constexpr size_t WS_WOUT = 16 * MiB, WS_WXQ = 18 * MiB, WS_WXO = 20 * MiB, WS_WUP = 22 * MiB, WS_WDN = 30 * MiB;
constexpr size_t WS_MKB = 38 * MiB, WS_MVB = 42 * MiB, WS_MVT = 46 * MiB;
constexpr size_t WS_XN = 50 * MiB;
constexpr size_t WS_LA = 87 * MiB;
constexpr size_t WS_X1 = 104 * MiB;
constexpr size_t WS_XB = 169 * MiB;
constexpr size_t WS_QX = 202 * MiB;
constexpr size_t WS_AO = 235 * MiB;
constexpr size_t WS_SB = 268 * MiB;
constexpr size_t WS_PROJ = 284 * MiB;
constexpr size_t WS_MIX = 349 * MiB;
constexpr size_t WS_KV = 382 * MiB;
constexpr size_t WS_HB = 284 * MiB;
constexpr size_t WS_END = 414 * MiB;

constexpr size_t O_YP = 0, O_YS = 16777216, O_CP = 16908288, O_CS = 17031168, O_GP = 18997248, O_GS = 19259392, O_MK = 23453696, O_MV = 25550848;

constexpr int LDS_BYTES = 147456;

__device__ __forceinline__ float bf2f(unsigned short b) { return __uint_as_float(((unsigned)b) << 16); }
__device__ __forceinline__ float bflo(unsigned w) { return __uint_as_float(w << 16); }
__device__ __forceinline__ float bfhi(unsigned w) { return __uint_as_float(w & 0xffff0000u); }
__device__ __forceinline__ unsigned short f2bf(float f) { return (unsigned short)(cvt_pk_bf16(f, 0.f) & 0xffffu); }
__device__ __forceinline__ float sigmoidf_(float x) { return 1.0f / (1.0f + __expf(-x)); }
__device__ __forceinline__ float siluf_(float x) { return x / (1.0f + __expf(-x)); }
__device__ __forceinline__ float wave_sum(float v) {
#pragma unroll
    for (int o = 1; o < 64; o <<= 1) v += __shfl_xor(v, o);
    return v;
}
__device__ __forceinline__ float wave_max(float v) {
#pragma unroll
    for (int o = 1; o < 64; o <<= 1) v = fmaxf(v, __shfl_xor(v, o));
    return v;
}
__device__ __forceinline__ u32x4 pack8(f32x4 a, f32x4 b) { u32x4 w; w.x = cvt_pk_bf16(a[0], a[1]); w.y = cvt_pk_bf16(a[2], a[3]); w.z = cvt_pk_bf16(b[0], b[1]); w.w = cvt_pk_bf16(b[2], b[3]); return w; }
#define LDS_WAIT() asm volatile("s_waitcnt lgkmcnt(0)" ::: "memory")

#define RLX_AGENT __ATOMIC_RELAXED, __HIP_MEMORY_SCOPE_AGENT
#define XB_TMO      128
#define XB_XCNT(j)  (256  + 64 * (j))
#define XB_XSUB(j)  (1280 + 64 * (j))
#define XB_XGEN(j)  (2304 + 64 * (j))
#define XB_TOP      3328
#define XB_TOPGEN   3392
#define XCD_BAR_WORDS 3456
#define XB_SPIN_CAP (1u << 18)

__device__ __forceinline__ unsigned xb_ld(unsigned* p)              { return __hip_atomic_load(p, __ATOMIC_RELAXED, __HIP_MEMORY_SCOPE_AGENT); }
__device__ __forceinline__ unsigned xb_add(unsigned* p, unsigned v) { return __hip_atomic_fetch_add(p, v, __ATOMIC_RELAXED, __HIP_MEMORY_SCOPE_AGENT); }
__device__ __forceinline__ unsigned xb_xcc_id() { return (unsigned)__builtin_amdgcn_s_getreg((3 << 11) | 20) & 0xFu; }
#define XB_SPIN(cond, bar) do { unsigned _sp = 0; while (cond) { __builtin_amdgcn_s_sleep(1); \
    if ((++_sp & 255u) == 0u) { if (xb_ld(&(bar)[XB_TMO])) break; if (_sp > XB_SPIN_CAP) { atomicAdd(&(bar)[XB_TMO], 1u); break; } } } } while (0)

struct XcdBarrier {
    unsigned* bar; unsigned x;
    volatile LAS unsigned* st;
};

__device__ __forceinline__ XcdBarrier xcd_barrier_post(unsigned* bar, volatile LAS unsigned* st) {
    XcdBarrier b; b.bar = bar; b.x = xb_xcc_id(); b.st = st;
    if (threadIdx.x == 0) (void)xb_add(&bar[XB_XCNT(b.x)], 1u);
    return b;
}
__device__ __forceinline__ void xcd_barrier_complete(unsigned* bar, unsigned x, unsigned& nloc, unsigned& nx) {
    const unsigned G = gridDim.x * gridDim.y * gridDim.z;
    unsigned sum, cnt, mine, sp = 0u;
    for (;;) {
        sum = 0u; cnt = 0u; mine = 0u;
#pragma unroll
        for (unsigned j = 0; j < 16; ++j) { const unsigned c = xb_ld(&bar[XB_XCNT(j)]); sum += c; cnt += (c > 0u) ? 1u : 0u; mine = (j == x) ? c : mine; }
        if (sum == G) break;
        __builtin_amdgcn_s_sleep(1);
        if ((++sp & 255u) == 0u) { if (xb_ld(&bar[XB_TMO])) break; if (sp > XB_SPIN_CAP) { atomicAdd(&bar[XB_TMO], 1u); break; } }
    }
    nloc = mine > 0u ? mine : 1u; nx = cnt > 0u ? cnt : 1u;
}

__device__ __forceinline__ void xcd_barrier(const XcdBarrier& b) {
    asm volatile("s_waitcnt vmcnt(0)" ::: "memory");
    __syncthreads();
    if (threadIdx.x == 0) {
        unsigned* bar = b.bar;
        __builtin_amdgcn_s_waitcnt(0);
        unsigned nloc = b.st[0], nx = b.st[1];
        if (nloc == 0u) { xcd_barrier_complete(bar, b.x, nloc, nx); b.st[0] = nloc; b.st[1] = nx; }
        const unsigned old = xb_add(&bar[XB_XSUB(b.x)], 1u);
        const unsigned gen = old / nloc;
        if (old + 1u == (gen + 1u) * nloc) {
            __builtin_amdgcn_fence(__ATOMIC_RELEASE, "agent");
            asm volatile("s_waitcnt vmcnt(0)" ::: "memory");
            const unsigned og = xb_add(&bar[XB_TOP], 1u);
            const unsigned tg = og / nx;
            if (og + 1u == (tg + 1u) * nx) xb_add(&bar[XB_TOPGEN], 1u);
            else XB_SPIN(xb_ld(&bar[XB_TOPGEN]) == tg, bar);
            __builtin_amdgcn_fence(__ATOMIC_ACQUIRE, "agent");
            xb_add(&bar[XB_XGEN(b.x)], 1u);
            asm volatile("s_waitcnt vmcnt(0)" ::: "memory");
        } else {
            XB_SPIN(xb_ld(&bar[XB_XGEN(b.x)]) == gen, bar);
            __builtin_amdgcn_fence(__ATOMIC_ACQUIRE, "agent");
            asm volatile("s_waitcnt vmcnt(0)" ::: "memory");
        }
    }
    __syncthreads();
}


struct Args { const float* in[27]; float* out; unsigned char* ws; int ph_lo, ph_hi; };

struct OrderRect {
    int nM, nN, nwg, G, c, n2M, n2N, pm2, pn2;
    __device__ void init(int nM_, int nN_, int G_, int c_, int n2M_ = 0, int n2N_ = 0, int pm2_ = 0, int pn2_ = 0) { nM = nM_; nN = nN_; nwg = nM * nN; G = G_; c = c_; n2M = n2M_; n2N = n2N_; pm2 = pm2_; pn2 = pn2_; }
    __device__ bool next(int i, pg8::Unit& u) const {
        long L = (long)i * G + c;
        if (L < nwg) {
            int wgid = (int)L; { const int q = nwg / 8, r = nwg % 8, xcd = wgid % 8, off = wgid / 8; wgid = (xcd < r ? xcd * (q + 1) : r * (q + 1) + (xcd - r) * q) + off; }
            const int nig = 8 * nN, gid = wgid / nig, fm = gid * 8, gsz = (nM - fm) < 8 ? (nM - fm) : 8;
            u.pm = fm + ((wgid % nig) % gsz); u.pn = (wgid % nig) / gsz; return true;
        }
        L -= nwg;
        if (L < (long)n2M * n2N) { u.pm = pm2 + (int)(L % n2M); u.pn = pn2 + (int)(L / n2M); return true; }
        return false;
    }
    __device__ __forceinline__ void a_ready(const pg8::Unit&) const {}
    __device__ __forceinline__ void done(const pg8::Unit&) const {}
};

struct EpiG1 {
    static constexpr bool PERM = true, AFTER_DRAIN = false;
    bf16* proj; float* la; const float* b_alpha; float* conv_p; float* conv_s; float* mk_out; float* mv_out; bf16* mkb; bf16* mvb;
    __device__ __forceinline__ void operator()(const f32x4 (&acc)[2][2][4][2], const pg8::Unit& u, int wr, int wc, int fr, int fq) const {
        const int pm = u.pm, pn = u.pn;
        if (pm < 65) {
            if (pn < 4) {
                const int ch = 128 * pn + 32 * wc + 8 * fq;
#pragma unroll
                for (int ai = 0; ai < 2; ++ai) {
                    if (256 * pm + 128 * ai >= NROW) continue;
#pragma unroll
                    for (int m = 0; m < 4; ++m) {
                        const int row = 256 * pm + 128 * ai + 64 * wr + 16 * m + fr;
                        f32x4 u0, u1;
#pragma unroll
                        for (int j = 0; j < 4; ++j) { u0[j] = acc[ai][0][m][0][j] * sigmoidf_(acc[ai][1][m][0][j]); u1[j] = acc[ai][0][m][1][j] * sigmoidf_(acc[ai][1][m][1][j]); }
                        *(u32x4*)(proj + (size_t)row * PJ + ch) = pack8(u0, u1);
                        if (row < NP) { const int t = row & (TSEQ - 1); if (t >= TSEQ - 30) { float* p = conv_p + ((size_t)((row >> 11) * 30 + (t - (TSEQ - 30)))) * 512 + ch; *(f32x4*)p = u0; *(f32x4*)(p + 4) = u1; } }
                        else { float* p = conv_s + ((size_t)((row - NP) * 30 + 29)) * 512 + ch; *(f32x4*)p = u0; *(f32x4*)(p + 4) = u1; }
                    }
                }
            } else if (pn < 10) {
                const bool act = pn >= 8;
#pragma unroll
                for (int ai = 0; ai < 2; ++ai) {
                    if (256 * pm + 128 * ai >= NROW) continue;
#pragma unroll
                    for (int m = 0; m < 4; ++m) {
                        const int row = 256 * pm + 128 * ai + 64 * wr + 16 * m + fr;
#pragma unroll
                        for (int bj = 0; bj < 2; ++bj) {
                            const int col = 512 + 256 * (pn - 4) + 128 * bj + 32 * wc + 8 * fq;
                            f32x4 v0 = acc[ai][bj][m][0], v1 = acc[ai][bj][m][1];
                            if (act) {
#pragma unroll
                                for (int j = 0; j < 4; ++j) { v0[j] = siluf_(v0[j]); v1[j] = siluf_(v1[j]); }
                            }
                            *(u32x4*)(proj + (size_t)row * PJ + col) = pack8(v0, v1);
                        }
                    }
                }
            } else {
#pragma unroll
                for (int bj = 0; bj < 2; ++bj) {
                    const int c = 128 * bj + 32 * wc + 8 * fq;
                    const f32x4 b0 = *(const f32x4*)(b_alpha + c), b1 = *(const f32x4*)(b_alpha + c + 4);
#pragma unroll
                    for (int ai = 0; ai < 2; ++ai) {
                        if (256 * pm + 128 * ai >= NROW) continue;
#pragma unroll
                        for (int m = 0; m < 4; ++m) {
                            const int row = 256 * pm + 128 * ai + 64 * wr + 16 * m + fr;
                            f32x4 z0 = acc[ai][bj][m][0] + b0, z1 = acc[ai][bj][m][1] + b1;
#pragma unroll
                            for (int j = 0; j < 4; ++j) {
                                z0[j] = (fminf(z0[j], 0.f) - __logf(1.0f + __expf(-fabsf(z0[j])))) * 0.0625f;
                                z1[j] = (fminf(z1[j], 0.f) - __logf(1.0f + __expf(-fabsf(z1[j])))) * 0.0625f;
                            }
                            float* p = la + (size_t)row * 256 + c; *(f32x4*)p = z0; *(f32x4*)(p + 4) = z1;
                        }
                    }
                }
            }
        } else {
            const int cb = 256 * (pn - 11);
            const bool isk = cb < 1024;
            float* of = isk ? mk_out : mv_out; bf16* ob = isk ? mkb : mvb; const int c0 = isk ? cb : cb - 1024;
#pragma unroll
            for (int ai = 0; ai < 2; ++ai)
#pragma unroll
                for (int m = 0; m < 4; ++m) {
                    const int row = 256 * (pm - 65) + 128 * ai + 64 * wr + 16 * m + fr;
#pragma unroll
                    for (int bj = 0; bj < 2; ++bj) {
                        const int col = c0 + 128 * bj + 32 * wc + 8 * fq;
                        const f32x4 v0 = acc[ai][bj][m][0], v1 = acc[ai][bj][m][1];
                        float* p = of + (size_t)row * 1024 + col; *(f32x4*)p = v0; *(f32x4*)(p + 4) = v1;
                        *(u32x4*)(ob + (size_t)row * 1024 + col) = pack8(v0, v1);
                    }
                }
        }
    }
};

struct EpiRes {
    static constexpr bool PERM = true, AFTER_DRAIN = false;
    const float* rp; const float* rs; float* op; float* os; bf16* ob; float* part;
    __device__ __forceinline__ void operator()(const f32x4 (&acc)[2][2][4][2], const pg8::Unit& u, int wr, int wc, int fr, int fq) const {
        const int pm = u.pm, pn = u.pn;
#pragma unroll
        for (int ai = 0; ai < 2; ++ai) {
            if (256 * pm + 128 * ai >= NROW) continue;
#pragma unroll
            for (int m = 0; m < 4; ++m) {
                const int row = 256 * pm + 128 * ai + 64 * wr + 16 * m + fr;
                const float* rr = row < NP ? rp + (size_t)row * D : rs + (size_t)(row - NP) * D;
                float* oo = row < NP ? op + (size_t)row * D : os + (size_t)(row - NP) * D;
                float ss = 0.f;
#pragma unroll
                for (int bj = 0; bj < 2; ++bj) {
                    const int col = 256 * pn + 128 * bj + 32 * wc + 8 * fq;
                    const f32x4 x0 = *(const f32x4*)(rr + col) + acc[ai][bj][m][0], x1 = *(const f32x4*)(rr + col + 4) + acc[ai][bj][m][1];
                    *(f32x4*)(oo + col) = x0; *(f32x4*)(oo + col + 4) = x1;
                    if (ob) *(u32x4*)(ob + (size_t)row * D + col) = pack8(x0, x1);
                    ss += (x0[0] * x0[0] + x0[1] * x0[1]) + (x0[2] * x0[2] + x0[3] * x0[3]) + (x1[0] * x1[0] + x1[1] * x1[1]) + (x1[2] * x1[2] + x1[3] * x1[3]);
                }
                ss += __shfl_xor(ss, 16); ss += __shfl_xor(ss, 32);
                if (fq == 0) part[(size_t)row * 16 + pn * 4 + wc] = ss;
            }
        }
    }
};

template <int MODE  > struct EpiScale {
    static constexpr bool PERM = true, AFTER_DRAIN = false;
    const float* part; bf16* o; int ldc;
    __device__ __forceinline__ void operator()(const f32x4 (&acc)[2][2][4][2], const pg8::Unit& u, int wr, int wc, int fr, int fq) const {
        const int pm = u.pm, pn = u.pn;
#pragma unroll
        for (int ai = 0; ai < 2; ++ai) {
            if (256 * pm + 128 * ai >= NROW) continue;
#pragma unroll
            for (int m = 0; m < 4; ++m) {
                const int row = 256 * pm + 128 * ai + 64 * wr + 16 * m + fr;
                const f32x4* pp = (const f32x4*)(part + (size_t)row * 16);
                const f32x4 p0 = pp[0], p1 = pp[1], p2 = pp[2], p3 = pp[3];
                const f32x4 ps = (p0 + p1) + (p2 + p3);
                const float rstd = rsqrtf(((ps[0] + ps[1]) + (ps[2] + ps[3])) * (1.0f / D) + EPS);
#pragma unroll
                for (int bj = 0; bj < 2; ++bj) {
                    const int col = 256 * pn + 128 * bj + 32 * wc + 8 * fq;
                    f32x4 v0 = acc[ai][bj][m][0] * rstd, v1 = acc[ai][bj][m][1] * rstd;
                    if (MODE == 1) {
#pragma unroll
                        for (int j = 0; j < 4; ++j) { const float a = fmaxf(v0[j], 0.f), b = fmaxf(v1[j], 0.f); v0[j] = a * a; v1[j] = b * b; }
                    }
                    *(u32x4*)(o + (size_t)row * ldc + col) = pack8(v0, v1);
                }
            }
        }
    }
};

__device__ __forceinline__ void transpose_item(const float* W, int N, int K, bf16* WT, int k0, int n0, int drow0, const float* gk, float sc, LAS float* scr, int lane) {
#pragma unroll 8
    for (int i = 0; i < 32; ++i) { const int kk = 2 * i + (lane >> 5); const float g = gk ? gk[k0 + kk] * sc : sc; scr[kk * 33 + (lane & 31)] = W[(size_t)(k0 + kk) * N + n0 + (lane & 31)] * g; }
    LDS_WAIT(); asm volatile("" ::: "memory");
    const int c = lane & 7;
#pragma unroll
    for (int j = 0; j < 4; ++j) { const int n = (lane >> 3) + 8 * j; const LAS float* s = scr + (8 * c) * 33 + n;
        u32x4 o; o.x = cvt_pk_bf16(s[0 * 33], s[1 * 33]); o.y = cvt_pk_bf16(s[2 * 33], s[3 * 33]); o.z = cvt_pk_bf16(s[4 * 33], s[5 * 33]); o.w = cvt_pk_bf16(s[6 * 33], s[7 * 33]);
        *(u32x4*)(WT + (size_t)(drow0 + n) * K + k0 + 8 * c) = o; }
    LDS_WAIT(); asm volatile("" ::: "memory");
}
__device__ __forceinline__ void norm_row_bf16(const float* xrow, const float* g, bf16* orow, int lane) {
    f32x4 v[4]; float s = 0.f;
#pragma unroll
    for (int j = 0; j < 4; ++j) { v[j] = ((const f32x4*)xrow)[lane + 64 * j]; s += (v[j][0] * v[j][0] + v[j][1] * v[j][1]) + (v[j][2] * v[j][2] + v[j][3] * v[j][3]); }
    const float rstd = rsqrtf(wave_sum(s) * (1.0f / D) + EPS);
#pragma unroll
    for (int j = 0; j < 4; ++j) { const f32x4 gv = ((const f32x4*)g)[lane + 64 * j]; const f32x4 o = v[j] * rstd * gv; u32x2 w; w.x = cvt_pk_bf16(o[0], o[1]); w.y = cvt_pk_bf16(o[2], o[3]); ((u32x2*)orow)[lane + 64 * j] = w; }
}
__device__ __forceinline__ void phase_prep(const Args& a, LAS unsigned char* lds, int G) {
    int tid_ = threadIdx.x; asm volatile("" : "+v"(tid_)); const int tid = tid_, lane = tid & 63, wave = tid >> 6;
    const int gw = blockIdx.x * 8 + wave, NGW = G * 8;
    unsigned char* ws = a.ws;
    LAS float* scr = (LAS float*)(lds + wave * 16384);
    bf16* wcat = (bf16*)(ws + WS_WCAT);
    constexpr int I_IN = 16 * 80, I_SQ = 16 * 32, I_UP = 16 * 128, I_DN = 64 * 32;
    constexpr int NITEMS = I_IN + 5 * I_SQ + I_UP + I_DN;
    for (int it = gw; it < NITEMS; it += NGW) {
        int r = it;
        if (r < I_IN) { const int kb = r / 80, nb = r % 80, n0 = nb * 32; int drow; float sc = 1.f;
            if (n0 < 512) drow = 256 * (n0 >> 7) + (n0 & 127);
            else if (n0 < 1024) { const int c = n0 - 512; drow = 256 * (c >> 7) + 128 + (c & 127); }
            else { drow = n0; if (n0 < 1280) sc = 0.125f; }
            transpose_item(a.in[8], 2576, D, wcat, kb * 64, n0, drow, nullptr, sc, scr, lane); continue; }
        r -= I_IN;
        if (r < I_SQ) { transpose_item(a.in[20], D, D, wcat, (r / 32) * 64, (r % 32) * 32, NIN + (r % 32) * 32, nullptr, 1.f, scr, lane); continue; } r -= I_SQ;
        if (r < I_SQ) { transpose_item(a.in[21], D, D, wcat, (r / 32) * 64, (r % 32) * 32, NIN + 1024 + (r % 32) * 32, nullptr, 1.f, scr, lane); continue; } r -= I_SQ;
        if (r < I_SQ) { transpose_item(a.in[16], D, D, (bf16*)(ws + WS_WOUT), (r / 32) * 64, (r % 32) * 32, (r % 32) * 32, nullptr, 1.f, scr, lane); continue; } r -= I_SQ;
        if (r < I_SQ) { transpose_item(a.in[19], D, D, (bf16*)(ws + WS_WXQ), (r / 32) * 64, (r % 32) * 32, (r % 32) * 32, a.in[17], 0.0625f, scr, lane); continue; } r -= I_SQ;
        if (r < I_SQ) { transpose_item(a.in[22], D, D, (bf16*)(ws + WS_WXO), (r / 32) * 64, (r % 32) * 32, (r % 32) * 32, nullptr, 1.f, scr, lane); continue; } r -= I_SQ;
        if (r < I_UP) { transpose_item(a.in[24], FF, D, (bf16*)(ws + WS_WUP), (r / 128) * 64, (r % 128) * 32, (r % 128) * 32, a.in[23], 1.f, scr, lane); continue; } r -= I_UP;
        transpose_item(a.in[25], D, FF, (bf16*)(ws + WS_WDN), (r / 32) * 64, (r % 32) * 32, (r % 32) * 32, nullptr, 1.f, scr, lane);
    }
    for (int idx = blockIdx.x * 512 + tid; idx < 256 * 1024; idx += G * 512) {
        const int j = idx >> 10, k = idx & 1023; const float* wr = a.in[8] + (size_t)k * 2576 + 2560; float s = 0.f;
#pragma unroll
        for (int r = 0; r < 16; ++r) s += wr[r] * a.in[9][r * 256 + j];
        wcat[(size_t)(2560 + j) * D + k] = f2bf(s);
    }
    bf16* xn = (bf16*)(ws + WS_XN);
    for (int m = gw; m < NROW + 2048; m += NGW) {
        if (m < NP) norm_row_bf16(a.in[0] + (size_t)m * D, a.in[7], xn + (size_t)m * D, lane);
        else if (m < NROW) norm_row_bf16(a.in[1] + (size_t)(m - NP) * D, a.in[7], xn + (size_t)m * D, lane);
        else norm_row_bf16(a.in[6] + (size_t)(m - NROW) * D, a.in[18], xn + (size_t)(MALL + (m - NROW)) * D, lane);
    }
}

__device__ __forceinline__ void conv_prompt_unit(LAS unsigned char* lds, const Args& a, int unit) {
    int tid_ = threadIdx.x; asm volatile("" : "+v"(tid_)); const int tid = tid_, lane = tid & 63, w = tid >> 6;
    const int b = unit >> 6, t0 = (unit & 63) * 32;
    const bf16* proj = (const bf16*)(a.ws + WS_PROJ); bf16* mix = (bf16*)(a.ws + WS_MIX);
    LAS bf16* in = (LAS bf16*)lds; LAS float* y = (LAS float*)(lds + 65536);
    __syncthreads();
#pragma unroll
    for (int it = 0; it < 8; ++it) { const int row = w + 8 * it; if (row < 62) { const int t = t0 - 30 + row; u32x4 v = {0u, 0u, 0u, 0u};
        if (t >= 0) v = *(const u32x4*)(proj + (size_t)(b * TSEQ + t) * PJ + 8 * lane); *(LAS u32x4*)(in + row * 512 + 8 * lane) = v; } }
    const int c = 64 * w + lane;
    float wgt[31];
#pragma unroll
    for (int k = 0; k < 31; ++k) wgt[k] = a.in[11][k * 512 + c];
    const float bias = a.in[12][c];
    __syncthreads();
    for (int tq = 0; tq < 8; ++tq) {
        float x[34];
#pragma unroll
        for (int k = 0; k < 34; ++k) x[k] = bf2f(in[(4 * tq + k) * 512 + c]);
        float a0 = bias, a1 = bias, a2 = bias, a3 = bias;
#pragma unroll
        for (int k = 0; k < 31; ++k) { a0 += wgt[k] * x[k]; a1 += wgt[k] * x[k + 1]; a2 += wgt[k] * x[k + 2]; a3 += wgt[k] * x[k + 3]; }
        y[(4 * tq + 0) * 512 + c] = a0; y[(4 * tq + 1) * 512 + c] = a1; y[(4 * tq + 2) * 512 + c] = a2; y[(4 * tq + 3) * 512 + c] = a3;
    }
    __syncthreads();
    const f32x4 g0 = *(const f32x4*)(a.in[13] + 8 * lane), g1 = *(const f32x4*)(a.in[13] + 8 * lane + 4), b0 = *(const f32x4*)(a.in[14] + 8 * lane), b1 = *(const f32x4*)(a.in[14] + 8 * lane + 4);
#pragma unroll
    for (int k = 0; k < 4; ++k) {
        const int t = w + 8 * k;
        f32x4 v0 = *(LAS f32x4*)(y + t * 512 + 8 * lane), v1 = *(LAS f32x4*)(y + t * 512 + 8 * lane + 4);
        const float mean = wave_sum((v0[0] + v0[1]) + (v0[2] + v0[3]) + (v1[0] + v1[1]) + (v1[2] + v1[3])) * (1.0f / 512.0f);
        v0 = v0 - mean; v1 = v1 - mean;
        const float var = wave_sum((v0[0] * v0[0] + v0[1] * v0[1]) + (v0[2] * v0[2] + v0[3] * v0[3]) + (v1[0] * v1[0] + v1[1] * v1[1]) + (v1[2] * v1[2] + v1[3] * v1[3])) * (1.0f / 512.0f);
        const float rstd = rsqrtf(var + EPS);
        v0 = v0 * rstd * g0 + b0; v1 = v1 * rstd * g1 + b1;
#pragma unroll
        for (int j = 0; j < 4; ++j) { v0[j] = siluf_(v0[j]); v1[j] = siluf_(v1[j]); }
        *(u32x4*)(mix + (size_t)(b * TSEQ + t0 + t) * D + 8 * lane) = pack8(v0, v1);
    }
}
__device__ __forceinline__ void conv_sample_unit(LAS unsigned char* lds, const Args& a, int b) {
    int tid_ = threadIdx.x; asm volatile("" : "+v"(tid_)); const int tid = tid_, lane = tid & 63, w = tid >> 6, c = tid;
    const bf16* proj = (const bf16*)(a.ws + WS_PROJ); bf16* mix = (bf16*)(a.ws + WS_MIX);
    LAS float* red = (LAS float*)lds;
    float* cs = a.out + O_CS;
    __syncthreads();
    float acc = a.in[12][c];
#pragma unroll 6
    for (int k = 0; k < 30; ++k) { const float v = a.in[2][(size_t)(b * 30 + k) * 512 + c]; acc += a.in[11][k * 512 + c] * v; if (k >= 1) cs[(size_t)(b * 30 + k - 1) * 512 + c] = v; }
    acc += a.in[11][30 * 512 + c] * bf2f(proj[(size_t)(NP + b) * PJ + c]);
    float s = wave_sum(acc); if (lane == 0) red[w] = s;
    __syncthreads();
    float mean = 0.f;
#pragma unroll
    for (int i = 0; i < 8; ++i) mean += red[i];
    mean *= (1.0f / 512.0f);
    const float dv = acc - mean;
    s = wave_sum(dv * dv); if (lane == 0) red[8 + w] = s;
    __syncthreads();
    float var = 0.f;
#pragma unroll
    for (int i = 0; i < 8; ++i) var += red[8 + i];
    const float o = dv * rsqrtf(var * (1.0f / 512.0f) + EPS) * a.in[13][c] + a.in[14][c];
    mix[(size_t)(NP + b) * D + c] = f2bf(siluf_(o));
}
__device__ __forceinline__ void gla1_unit(LAS unsigned char* lds, const Args& a, int unit) {
    int tid_ = threadIdx.x; asm volatile("" : "+v"(tid_)); const int tid = tid_, lane = tid & 63, w = tid >> 6;
    const int bh = unit >> 5, n = unit & 31, b = bh >> 2, h = bh & 3, r0 = b * TSEQ + n * CH;
    const bf16* proj = (const bf16*)(a.ws + WS_PROJ); float* la = (float*)(a.ws + WS_LA); float* kv = (float*)(a.ws + WS_KV); float* dec = (float*)(a.ws + WS_DEC);
    LAS unsigned char* kT = lds; LAS unsigned char* vT = lds + 9216; LAS float* segtot = (LAS float*)(lds + 27648);
    const int d = tid & 63, seg = w;
    __syncthreads();
    float c[8]; float run = 0.f;
#pragma unroll
    for (int j = 0; j < 8; ++j) { run += la[(size_t)(r0 + 8 * seg + j) * 256 + h * 64 + d]; c[j] = run; }
    segtot[seg * 64 + d] = run;
    { const int dv = tid & 127, s4 = tid >> 7; unsigned pk[8];
#pragma unroll
        for (int jj = 0; jj < 8; ++jj) { const unsigned lo = proj[(size_t)(r0 + 16 * s4 + 2 * jj) * PJ + PJ_V + h * 128 + dv], hi = proj[(size_t)(r0 + 16 * s4 + 2 * jj + 1) * PJ + PJ_V + h * 128 + dv]; pk[jj] = lo | (hi << 16); }
        *(LAS u32x4*)(vT + dv * 144 + s4 * 32) = (u32x4){pk[0], pk[1], pk[2], pk[3]}; *(LAS u32x4*)(vT + dv * 144 + s4 * 32 + 16) = (u32x4){pk[4], pk[5], pk[6], pk[7]}; }
    __syncthreads();
    float off = 0.f, tot = 0.f;
#pragma unroll
    for (int s = 0; s < 8; ++s) { const float t = segtot[s * 64 + d]; tot += t; if (s < seg) off += t; }
    float kin[8];
#pragma unroll
    for (int j = 0; j < 8; ++j) { const float bj = c[j] + off; la[(size_t)(r0 + 8 * seg + j) * 256 + h * 64 + d] = bj;
        kin[j] = bf2f(proj[(size_t)(r0 + 8 * seg + j) * PJ + PJ_K + h * 64 + d]) * __expf(tot - bj); }
    *(LAS u32x4*)(kT + d * 144 + seg * 16) = (u32x4){cvt_pk_bf16(kin[0], kin[1]), cvt_pk_bf16(kin[2], kin[3]), cvt_pk_bf16(kin[4], kin[5]), cvt_pk_bf16(kin[6], kin[7])};
    if (seg == 0) dec[(size_t)(bh * NCHUNK + n) * 64 + d] = __expf(tot);
    __syncthreads();
    const int mb = w >> 2, nb = w & 3, nn = lane & 31, g = lane >> 5;
    f32x16 acc;
#pragma unroll
    for (int i = 0; i < 16; ++i) acc[i] = 0.f;
#pragma unroll
    for (int s = 0; s < 4; ++s) { const bf16x8 af = *(LAS bf16x8*)(kT + (32 * mb + nn) * 144 + (16 * s + 8 * g) * 2), bfv = *(LAS bf16x8*)(vT + (32 * nb + nn) * 144 + (16 * s + 8 * g) * 2);
        acc = __builtin_amdgcn_mfma_f32_32x32x16_bf16(af, bfv, acc, 0, 0, 0); }
#pragma unroll
    for (int i = 0; i < 16; ++i) { const int dd = 32 * mb + 8 * (i >> 2) + 4 * g + (i & 3); kv[((size_t)(bh * NCHUNK + n) * 64 + dd) * 128 + 32 * nb + nn] = acc[i]; }
}
__device__ __forceinline__ void gla_sample_unit(LAS unsigned char* lds, const Args& a, int unit) {
    int tid_ = threadIdx.x; asm volatile("" : "+v"(tid_)); const int tid = tid_, lane = tid & 63, w = tid >> 6;
    const int b = unit >> 2, h = unit & 3, row = NP + b;
    const bf16* proj = (const bf16*)(a.ws + WS_PROJ); const float* la = (const float*)(a.ws + WS_LA); bf16* mix = (bf16*)(a.ws + WS_MIX);
    LAS float* red = (LAS float*)lds;
    LAS float* red2 = red + 2048;
    const int dv = 4 * (tid & 31), dg = tid >> 5;
    __syncthreads();
    const u32x2 vv = *(const u32x2*)(proj + (size_t)row * PJ + PJ_V + h * 128 + dv);
    const f32x4 v4 = {bflo(vv.x), bfhi(vv.x), bflo(vv.y), bfhi(vv.y)};
    f32x4 o4 = {0.f, 0.f, 0.f, 0.f};
#pragma unroll
    for (int dd = 0; dd < 4; ++dd) { const int d = 4 * dg + dd;
        const float al = __expf(la[(size_t)row * 256 + h * 64 + d]), kk = bf2f(proj[(size_t)row * PJ + PJ_K + h * 64 + d]), qq = bf2f(proj[(size_t)row * PJ + PJ_Q + h * 64 + d]);
        const size_t so = ((size_t)(b * 4 + h) * 64 + d) * 128 + dv;
        const f32x4 sn = *(const f32x4*)(a.in[3] + so) * al + v4 * kk;
        *(f32x4*)(a.out + O_GS + so) = sn; o4 = o4 + sn * qq; }
    *(LAS f32x4*)(red + dg * 128 + dv) = o4;
    __syncthreads();
    float o = 0.f;
    if (tid < 128) {
#pragma unroll
        for (int i = 0; i < 16; ++i) o += red[i * 128 + tid];
        const float ss = wave_sum(o * o); if (lane == 0) red2[w] = ss;
    }
    __syncthreads();
    if (tid < 128) { const float rstd = rsqrtf((red2[0] + red2[1]) * (1.0f / 128.0f) + EPS);
        mix[(size_t)row * D + 512 + h * 128 + tid] = f2bf(o * rstd * a.in[15][tid] * bf2f(proj[(size_t)row * PJ + PJ_R + h * 128 + tid])); }
}
__device__ __forceinline__ void vt_unit(const Args& a, int unit) {
    int tid_ = threadIdx.x; asm volatile("" : "+v"(tid_)); const int tid = tid_, b = unit >> 2, h = unit & 3, hd = tid & 255, ms = tid >> 8;
    const bf16* mvb = (const bf16*)(a.ws + WS_MVB); bf16* mvt = (bf16*)(a.ws + WS_MVT);
    for (int mc = 0; mc < 16; ++mc) { const int m0 = ms * 128 + mc * 8; unsigned pk[4];
#pragma unroll
        for (int j = 0; j < 4; ++j) { const unsigned lo = mvb[(size_t)(b * 256 + m0 + 2 * j) * D + h * 256 + hd], hi = mvb[(size_t)(b * 256 + m0 + 2 * j + 1) * D + h * 256 + hd]; pk[j] = lo | (hi << 16); }
        *(u32x4*)(mvt + ((size_t)(b * 4 + h) * 256 + hd) * 256 + m0) = (u32x4){pk[0], pk[1], pk[2], pk[3]}; }
}

__device__ __forceinline__ void phase_scan(const Args& a, int G) {
    const float* kv = (const float*)(a.ws + WS_KV); const float* dec = (const float*)(a.ws + WS_DEC); bf16* sb = (bf16*)(a.ws + WS_SB);
    typedef float f32x2 __attribute__((ext_vector_type(2)));
    for (int p = blockIdx.x * 512 + threadIdx.x; p < 32 * 4096; p += G * 512) {
        const int bh = p >> 12, e = (p & 4095) * 2, d = e >> 7;
        f32x2 S = {0.f, 0.f};
#pragma unroll 8
        for (int n = 0; n < NCHUNK; ++n) {
            const size_t o = (size_t)(bh * NCHUNK + n) * 8192 + e;
            const f32x2 k2 = *(const f32x2*)(kv + o); const float dc = dec[(size_t)(bh * NCHUNK + n) * 64 + d];
            *(unsigned*)(sb + o) = cvt_pk_bf16(S[0], S[1]);
            S = S * dc + k2;
        }
        *(f32x2*)(a.out + O_GP + (size_t)bh * 8192 + e) = S;
    }
}

__device__ __forceinline__ void gla3_unit(LAS unsigned char* lds, const Args& a, int unit) {
    int tid_ = threadIdx.x; asm volatile("" : "+v"(tid_)); const int tid = tid_, lane = tid & 63, w = tid >> 6;
    const int bh = unit >> 5, n = unit & 31, b = bh >> 2, h = bh & 3, r0 = b * TSEQ + n * CH;
    const bf16* proj = (const bf16*)(a.ws + WS_PROJ); const float* la = (const float*)(a.ws + WS_LA); const bf16* sb = (const bf16*)(a.ws + WS_SB); bf16* mix = (bf16*)(a.ws + WS_MIX);
    LAS unsigned char* vT = lds; LAS unsigned char* sT = lds + 18432; LAS unsigned char* P = lds + 36864; LAS unsigned char* qin = lds + 46080; LAS unsigned char* kt = lds + 55296;
    LAS float* O = (LAS float*)(lds + 64512);
    __syncthreads();
    { const int d = tid & 63, seg = w;
#pragma unroll
        for (int j = 0; j < 8; ++j) { const int t = 8 * seg + j; const float bb = la[(size_t)(r0 + t) * 256 + h * 64 + d];
            const float q = bf2f(proj[(size_t)(r0 + t) * PJ + PJ_Q + h * 64 + d]), k = bf2f(proj[(size_t)(r0 + t) * PJ + PJ_K + h * 64 + d]);
            *(LAS bf16*)(qin + t * 144 + d * 2) = f2bf(q * __expf(bb)); *(LAS bf16*)(kt + t * 144 + d * 2) = f2bf(k * __expf(-bb)); } }
    { const int dv = tid & 127, s4 = tid >> 7; unsigned pk[8];
#pragma unroll
        for (int jj = 0; jj < 8; ++jj) { const unsigned lo = proj[(size_t)(r0 + 16 * s4 + 2 * jj) * PJ + PJ_V + h * 128 + dv], hi = proj[(size_t)(r0 + 16 * s4 + 2 * jj + 1) * PJ + PJ_V + h * 128 + dv]; pk[jj] = lo | (hi << 16); }
        *(LAS u32x4*)(vT + dv * 144 + s4 * 32) = (u32x4){pk[0], pk[1], pk[2], pk[3]}; *(LAS u32x4*)(vT + dv * 144 + s4 * 32 + 16) = (u32x4){pk[4], pk[5], pk[6], pk[7]};
        const bf16* sp = sb + (size_t)(bh * NCHUNK + n) * 8192;
#pragma unroll
        for (int jj = 0; jj < 8; ++jj) { const unsigned lo = sp[(16 * s4 + 2 * jj) * 128 + dv], hi = sp[(16 * s4 + 2 * jj + 1) * 128 + dv]; pk[jj] = lo | (hi << 16); }
        *(LAS u32x4*)(sT + dv * 144 + s4 * 32) = (u32x4){pk[0], pk[1], pk[2], pk[3]}; *(LAS u32x4*)(sT + dv * 144 + s4 * 32 + 16) = (u32x4){pk[4], pk[5], pk[6], pk[7]}; }
    __syncthreads();
    const int nn = lane & 31, g = lane >> 5;
    if (w < 4) { const int ib = w >> 1, jb = w & 1;
        f32x16 acc;
#pragma unroll
        for (int i = 0; i < 16; ++i) acc[i] = 0.f;
#pragma unroll
        for (int s = 0; s < 4; ++s) { const bf16x8 af = *(LAS bf16x8*)(qin + (32 * ib + nn) * 144 + (16 * s + 8 * g) * 2), bfv = *(LAS bf16x8*)(kt + (32 * jb + nn) * 144 + (16 * s + 8 * g) * 2);
            acc = __builtin_amdgcn_mfma_f32_32x32x16_bf16(af, bfv, acc, 0, 0, 0); }
#pragma unroll
        for (int i = 0; i < 16; ++i) { const int ii = 32 * ib + 8 * (i >> 2) + 4 * g + (i & 3), jj = 32 * jb + nn; *(LAS bf16*)(P + ii * 144 + jj * 2) = f2bf(jj <= ii ? acc[i] : 0.f); } }
    __syncthreads();
    { const int ib = w >> 2, nb = w & 3;
        f32x16 acc;
#pragma unroll
        for (int i = 0; i < 16; ++i) acc[i] = 0.f;
#pragma unroll
        for (int s = 0; s < 4; ++s) { const bf16x8 af = *(LAS bf16x8*)(P + (32 * ib + nn) * 144 + (16 * s + 8 * g) * 2), bfv = *(LAS bf16x8*)(vT + (32 * nb + nn) * 144 + (16 * s + 8 * g) * 2);
            acc = __builtin_amdgcn_mfma_f32_32x32x16_bf16(af, bfv, acc, 0, 0, 0); }
#pragma unroll
        for (int s = 0; s < 4; ++s) { const bf16x8 af = *(LAS bf16x8*)(qin + (32 * ib + nn) * 144 + (16 * s + 8 * g) * 2), bfv = *(LAS bf16x8*)(sT + (32 * nb + nn) * 144 + (16 * s + 8 * g) * 2);
            acc = __builtin_amdgcn_mfma_f32_32x32x16_bf16(af, bfv, acc, 0, 0, 0); }
#pragma unroll
        for (int i = 0; i < 16; ++i) { const int ii = 32 * ib + 8 * (i >> 2) + 4 * g + (i & 3); O[ii * 132 + 32 * nb + nn] = acc[i]; } }
    __syncthreads();
    { const int i = tid >> 3, part = tid & 7; f32x4 o[4]; float ss = 0.f;
#pragma unroll
        for (int j = 0; j < 4; ++j) { o[j] = *(LAS f32x4*)(O + i * 132 + 16 * part + 4 * j); ss += (o[j][0] * o[j][0] + o[j][1] * o[j][1]) + (o[j][2] * o[j][2] + o[j][3] * o[j][3]); }
        ss += __shfl_xor(ss, 1); ss += __shfl_xor(ss, 2); ss += __shfl_xor(ss, 4);
        const float rstd = rsqrtf(ss * (1.0f / 128.0f) + EPS);
        const size_t row = (size_t)(r0 + i);
        const u32x4 r0v = *(const u32x4*)(proj + row * PJ + PJ_R + h * 128 + 16 * part), r1v = *(const u32x4*)(proj + row * PJ + PJ_R + h * 128 + 16 * part + 8);
        const float* gg = a.in[15] + 16 * part;
        const unsigned rw[8] = {r0v.x, r0v.y, r0v.z, r0v.w, r1v.x, r1v.y, r1v.z, r1v.w};
        unsigned ow[8];
#pragma unroll
        for (int j = 0; j < 8; ++j) { const float x0 = o[j >> 1][(j & 1) * 2] * rstd * gg[2 * j] * bflo(rw[j]), x1 = o[j >> 1][(j & 1) * 2 + 1] * rstd * gg[2 * j + 1] * bfhi(rw[j]); ow[j] = cvt_pk_bf16(x0, x1); }
        bf16* op = mix + row * D + 512 + h * 128 + 16 * part;
        *(u32x4*)op = (u32x4){ow[0], ow[1], ow[2], ow[3]}; *(u32x4*)(op + 8) = (u32x4){ow[4], ow[5], ow[6], ow[7]}; }
}

__device__ __forceinline__ void attn_prompt_unit(LAS unsigned char* lds, const Args& a, int unit) {
    int tid_ = threadIdx.x; asm volatile("" : "+v"(tid_)); const int tid = tid_, lane = tid & 63, w = tid >> 6, nn = lane & 31, g = lane >> 5;
    const int b = unit >> 5, h = (unit >> 3) & 3, qt = unit & 7;
    const bf16* qx = (const bf16*)(a.ws + WS_QX); const bf16* mkb = (const bf16*)(a.ws + WS_MKB); const bf16* mvt = (const bf16*)(a.ws + WS_MVT); bf16* ao = (bf16*)(a.ws + WS_AO);
    const size_t qrow = (size_t)b * TSEQ + qt * 256 + 32 * w + nn;
    __syncthreads();
#pragma unroll 4
    for (int it = 0; it < 16; ++it) { const int row = (tid >> 5) + 16 * it, ch = tid & 31;
        *(LAS u32x4*)(lds + row * 528 + ch * 16) = *(const u32x4*)(mkb + (size_t)(b * 256 + row) * D + h * 256 + ch * 8); }
    bf16x8 qf[16];
#pragma unroll
    for (int s = 0; s < 16; ++s) qf[s] = *(const bf16x8*)(qx + qrow * D + h * 256 + 16 * s + 8 * g);
    __syncthreads();
    f32x16 acc[8];
#pragma unroll
    for (int kb = 0; kb < 8; ++kb) {
#pragma unroll
        for (int i = 0; i < 16; ++i) acc[kb][i] = 0.f;
#pragma unroll
        for (int s = 0; s < 16; ++s) { const bf16x8 af = *(LAS bf16x8*)(lds + (32 * kb + nn) * 528 + (16 * s + 8 * g) * 2); acc[kb] = __builtin_amdgcn_mfma_f32_32x32x16_bf16(af, qf[s], acc[kb], 0, 0, 0); }
    }
    float mx = -3.0e38f;
#pragma unroll
    for (int kb = 0; kb < 8; ++kb)
#pragma unroll
        for (int i = 0; i < 16; ++i) mx = fmaxf(mx, acc[kb][i]);
    mx = fmaxf(mx, __shfl_xor(mx, 32));
    float sum = 0.f;
    u32x4 pb[8][2];
#pragma unroll
    for (int kb = 0; kb < 8; ++kb) {
#pragma unroll
        for (int i = 0; i < 16; ++i) { const float p = __expf(acc[kb][i] - mx); sum += p; acc[kb][i] = p; }
#pragma unroll
        for (int hh = 0; hh < 2; ++hh) { pb[kb][hh].x = cvt_pk_bf16(acc[kb][8 * hh + 0], acc[kb][8 * hh + 1]); pb[kb][hh].y = cvt_pk_bf16(acc[kb][8 * hh + 2], acc[kb][8 * hh + 3]);
            pb[kb][hh].z = cvt_pk_bf16(acc[kb][8 * hh + 4], acc[kb][8 * hh + 5]); pb[kb][hh].w = cvt_pk_bf16(acc[kb][8 * hh + 6], acc[kb][8 * hh + 7]); }
    }
    sum += __shfl_xor(sum, 32);
    const float inv = 1.0f / sum;
    __syncthreads();
#pragma unroll 4
    for (int it = 0; it < 16; ++it) { const int row = (tid >> 5) + 16 * it, ch = tid & 31;
        *(LAS u32x4*)(lds + row * 528 + ch * 16) = *(const u32x4*)(mvt + ((size_t)(b * 4 + h) * 256 + row) * 256 + ch * 8); }
    __syncthreads();
#pragma unroll
    for (int mb = 0; mb < 8; ++mb) {
        f32x16 o;
#pragma unroll
        for (int i = 0; i < 16; ++i) o[i] = 0.f;
#pragma unroll
        for (int kb = 0; kb < 8; ++kb)
#pragma unroll
            for (int hh = 0; hh < 2; ++hh) { const int base = 32 * kb + 16 * hh;
                const u32x2 lo = *(LAS u32x2*)(lds + (32 * mb + nn) * 528 + (base + 4 * g) * 2), hi = *(LAS u32x2*)(lds + (32 * mb + nn) * 528 + (base + 8 + 4 * g) * 2);
                const u32x4 av = {lo.x, lo.y, hi.x, hi.y};
                o = __builtin_amdgcn_mfma_f32_32x32x16_bf16(__builtin_bit_cast(bf16x8, av), __builtin_bit_cast(bf16x8, pb[kb][hh]), o, 0, 0, 0); }
#pragma unroll
        for (int i4 = 0; i4 < 4; ++i4) { u32x2 wv; wv.x = cvt_pk_bf16(o[4 * i4] * inv, o[4 * i4 + 1] * inv); wv.y = cvt_pk_bf16(o[4 * i4 + 2] * inv, o[4 * i4 + 3] * inv);
            *(u32x2*)(ao + qrow * D + h * 256 + 32 * mb + 8 * i4 + 4 * g) = wv; }
    }
}
__device__ __forceinline__ void attn_sample_unit(LAS unsigned char* lds, const Args& a, int unit) {
    int tid_ = threadIdx.x; asm volatile("" : "+v"(tid_)); const int tid = tid_, lane = tid & 63, w = tid >> 6;
    const int b = unit >> 2, h = unit & 3;
    const bf16* qx = (const bf16*)(a.ws + WS_QX); bf16* ao = (bf16*)(a.ws + WS_AO);
    LAS float* sc = (LAS float*)lds; LAS float* red = sc + 256;
    const u32x2 qq = *(const u32x2*)(qx + (size_t)(NP + b) * D + h * 256 + 4 * lane);
    const f32x4 q4 = {bflo(qq.x), bfhi(qq.x), bflo(qq.y), bfhi(qq.y)};
    const float* kbase = a.in[4] + ((size_t)b * 256 * 4 + h) * 256 + 4 * lane;
    const float* vbase = a.in[5] + ((size_t)b * 256 * 4 + h) * 256 + 4 * lane;
    __syncthreads();
#pragma unroll 1
    for (int c = 0; c < 4; ++c) {
        f32x4 kv[8];
#pragma unroll
        for (int j = 0; j < 8; ++j) kv[j] = *(const f32x4*)(kbase + (size_t)(32 * w + 8 * c + j) * 1024);
#pragma unroll
        for (int j = 0; j < 8; ++j) { const float dsum = wave_sum((kv[j][0] * q4[0] + kv[j][1] * q4[1]) + (kv[j][2] * q4[2] + kv[j][3] * q4[3])); if (lane == j) sc[32 * w + 8 * c + j] = dsum; }
    }
    __syncthreads();
    const float s0 = sc[lane], s1 = sc[64 + lane], s2 = sc[128 + lane], s3 = sc[192 + lane];
    const float mx = wave_max(fmaxf(fmaxf(s0, s1), fmaxf(s2, s3)));
    const float inv = 1.0f / wave_sum((__expf(s0 - mx) + __expf(s1 - mx)) + (__expf(s2 - mx) + __expf(s3 - mx)));
    f32x4 o4 = {0.f, 0.f, 0.f, 0.f};
#pragma unroll 1
    for (int c = 0; c < 4; ++c) {
        f32x4 vv[8];
#pragma unroll
        for (int j = 0; j < 8; ++j) vv[j] = *(const f32x4*)(vbase + (size_t)(32 * w + 8 * c + j) * 1024);
#pragma unroll
        for (int j = 0; j < 8; ++j) { const float p = __expf(sc[32 * w + 8 * c + j] - mx) * inv; o4 = o4 + vv[j] * p; }
    }
    *(LAS f32x4*)(red + w * 256 + 4 * lane) = o4;
    __syncthreads();
    if (tid < 256) { float o = 0.f;
#pragma unroll
        for (int i = 0; i < 8; ++i) o += red[i * 256 + tid];
        ao[(size_t)(NP + b) * D + h * 256 + tid] = f2bf(o); }
}

__device__ __forceinline__ void phase_final(const Args& a, int G) {
    int tid_ = threadIdx.x; asm volatile("" : "+v"(tid_)); const int tid = tid_, lane = tid & 63, wave = tid >> 6;
    const float* part = (const float*)(a.ws + WS_PART + 2 * PART_BYTES);
    for (int m = blockIdx.x * 8 + wave; m < NROW; m += G * 8) {
        float* y = a.out + (m < NP ? O_YP + (size_t)m * D : O_YS + (size_t)(m - NP) * D);
        const float pv = lane < 16 ? part[(size_t)m * 16 + lane] : 0.f;
        const float rstd = rsqrtf(wave_sum(pv) * (1.0f / D) + EPS);
#pragma unroll
        for (int j = 0; j < 4; ++j) { const f32x4 gv = ((const f32x4*)a.in[26])[lane + 64 * j]; f32x4 v = ((f32x4*)y)[lane + 64 * j]; ((f32x4*)y)[lane + 64 * j] = v * rstd * gv; }
    }
}

__global__ void __launch_bounds__(512, 2) hybrid_fwd(Args a) {
    extern __shared__ __attribute__((aligned(16))) unsigned char lds_raw[];
    LAS unsigned char* lds = (LAS unsigned char*)lds_raw;
    cg::grid_group grid = cg::this_grid();
    const int G = gridDim.x, bx = blockIdx.x;
    unsigned char* ws = a.ws;
    const int lo = a.ph_lo, hi = a.ph_hi;
    volatile LAS unsigned* bst = (volatile LAS unsigned*)(lds + LDS_BYTES - 64);
    if (threadIdx.x < 2) bst[threadIdx.x] = 0u;
    __syncthreads();
    XcdBarrier bar = xcd_barrier_post((unsigned*)ws, bst);
    if (lo < 0) grid.sync();
#define IN(k) (lo <= (k) && (k) < hi)
#define SEAM(k) do { if (IN(k) && IN((k) + 1)) xcd_barrier(bar); } while (0)

    if (IN(0)) phase_prep(a, lds, G);
    SEAM(0);
    if (IN(1)) {
        __syncthreads();
        pg8::Gemm g{(const bf16*)(ws + WS_XN), (const bf16*)(ws + WS_WCAT), 0, 0, D}; OrderRect S; S.init(65, 11, G, bx, 8, 8, 65, 11);
        EpiG1 E{(bf16*)(ws + WS_PROJ), (float*)(ws + WS_LA), a.in[10], a.out + O_CP, a.out + O_CS, a.out + O_MK, a.out + O_MV, (bf16*)(ws + WS_MKB), (bf16*)(ws + WS_MVB)};
        pg8::gemm_phase<EpiG1, OrderRect, true, true>(lds, g, S, E);
    }
    SEAM(1);
    if (IN(2)) {
        constexpr int U_CONV = 512, U_G1 = 1024, U_CS = 128, U_GS = 512, U_VT = 32, U_ALL = U_CONV + U_G1 + U_CS + U_GS + U_VT;
        for (int u = bx; u < U_ALL; u += G) {
            int r = u;
            if (r < U_G1) { gla1_unit(lds, a, r); continue; } r -= U_G1;
            if (r < U_CONV) { conv_prompt_unit(lds, a, r); continue; } r -= U_CONV;
            if (r < U_GS) { gla_sample_unit(lds, a, r); continue; } r -= U_GS;
            if (r < U_CS) { conv_sample_unit(lds, a, r); continue; } r -= U_CS;
            vt_unit(a, r);
        }
    }
    SEAM(2);
    if (IN(3)) phase_scan(a, G);
    SEAM(3);
    if (IN(4)) { for (int u = bx; u < 1024; u += G) gla3_unit(lds, a, u); }
    SEAM(4);
    if (IN(5)) {
        __syncthreads();
        pg8::Gemm g{(const bf16*)(ws + WS_MIX), (const bf16*)(ws + WS_WOUT), 0, 0, D}; OrderRect S; S.init(65, 4, G, bx);
        EpiRes E{a.in[0], a.in[1], (float*)(ws + WS_X1), (float*)(ws + WS_X1) + (size_t)NP * D, (bf16*)(ws + WS_XB), (float*)(ws + WS_PART)};
        pg8::gemm_phase<EpiRes, OrderRect, true, true>(lds, g, S, E);
    }
    SEAM(5);
    if (IN(6)) {
        __syncthreads();
        pg8::Gemm g{(const bf16*)(ws + WS_XB), (const bf16*)(ws + WS_WXQ), 0, 0, D}; OrderRect S; S.init(65, 4, G, bx);
        EpiScale<0> E{(const float*)(ws + WS_PART), (bf16*)(ws + WS_QX), D};
        pg8::gemm_phase<EpiScale<0>, OrderRect, true, true>(lds, g, S, E);
    }
    SEAM(6);
    if (IN(7)) {
        for (int u = bx; u < 256 + 512; u += G) { if (u < 256) attn_prompt_unit(lds, a, u); else attn_sample_unit(lds, a, u - 256); }
    }
    SEAM(7);
    if (IN(8)) {
        __syncthreads();
        pg8::Gemm g{(const bf16*)(ws + WS_AO), (const bf16*)(ws + WS_WXO), 0, 0, D}; OrderRect S; S.init(65, 4, G, bx);
        float* x1 = (float*)(ws + WS_X1);
        EpiRes E{x1, x1 + (size_t)NP * D, x1, x1 + (size_t)NP * D, (bf16*)(ws + WS_XB), (float*)(ws + WS_PART + PART_BYTES)};
        pg8::gemm_phase<EpiRes, OrderRect, true, true>(lds, g, S, E);
    }
    SEAM(8);
    if (IN(9)) {
        __syncthreads();
        pg8::Gemm g{(const bf16*)(ws + WS_XB), (const bf16*)(ws + WS_WUP), 0, 0, D}; OrderRect S; S.init(65, 16, G, bx);
        EpiScale<1> E{(const float*)(ws + WS_PART + PART_BYTES), (bf16*)(ws + WS_HB), FF};
        pg8::gemm_phase<EpiScale<1>, OrderRect, true, true>(lds, g, S, E);
    }
    SEAM(9);
    if (IN(10)) {
        __syncthreads();
        pg8::Gemm g{(const bf16*)(ws + WS_HB), (const bf16*)(ws + WS_WDN), 0, 0, FF}; OrderRect S; S.init(65, 4, G, bx);
        float* x1 = (float*)(ws + WS_X1);
        EpiRes E{x1, x1 + (size_t)NP * D, a.out + O_YP, a.out + O_YS, nullptr, (float*)(ws + WS_PART + 2 * PART_BYTES)};
        pg8::gemm_phase<EpiRes, OrderRect, true, true>(lds, g, S, E);
    }
    SEAM(10);
    if (IN(11)) phase_final(a, G);
#undef IN
#undef SEAM
}

#ifndef N_LAUNCHES
#define N_LAUNCHES 1
#endif
extern "C" void kernel_launch(void* const* d_in, const int* in_sizes, int n_in, void* d_out, int out_size, void* d_ws, size_t ws_size, hipStream_t stream) {
    static int grid = 0;
    if (grid == 0) {
        if (n_in != 27 || ws_size < WS_END) { fprintf(stderr, "kernel_launch: unexpected n_in %d / ws %zu\n", n_in, ws_size); grid = -1; return; }
        int dev = 0, cus = 0, per_cu = 0;
        (void)hipGetDevice(&dev); (void)hipDeviceGetAttribute(&cus, hipDeviceAttributeMultiprocessorCount, dev);
        if (hipFuncSetAttribute((const void*)hybrid_fwd, hipFuncAttributeMaxDynamicSharedMemorySize, LDS_BYTES) != hipSuccess) { fprintf(stderr, "kernel_launch: hipFuncSetAttribute failed\n"); grid = -1; return; }
        if (hipOccupancyMaxActiveBlocksPerMultiprocessor(&per_cu, (const void*)hybrid_fwd, 512, LDS_BYTES) != hipSuccess || per_cu < 1) { fprintf(stderr, "kernel_launch: occupancy query says %d\n", per_cu); per_cu = 1; }
        (void)hipGetLastError();
        grid = cus * 1;
        fprintf(stderr, "kernel_launch: grid %d (cus %d, per_cu %d)\n", grid, cus, per_cu);
    }
    if (grid < 0) return;
    if (hipMemsetAsync(d_ws, 0, 16384, stream) != hipSuccess) { fprintf(stderr, "kernel_launch: memset failed\n"); return; }
    Args a{};
    for (int i = 0; i < 27; ++i) a.in[i] = (const float*)d_in[i];
    a.out = (float*)d_out; a.ws = (unsigned char*)d_ws;
    if (N_LAUNCHES == 1) {
        a.ph_lo = 0; a.ph_hi = 12;
        void* args[] = {&a};
        hipError_t e = hipLaunchCooperativeKernel((const void*)hybrid_fwd, dim3(grid), dim3(512), args, LDS_BYTES, stream);
        if (e != hipSuccess) fprintf(stderr, "cooperative launch failed: %s (grid %d)\n", hipGetErrorString(e), grid);
    } else {
        for (int p = 0; p < 12; ++p) { a.ph_lo = p; a.ph_hi = p + 1; hipLaunchKernelGGL(hybrid_fwd, dim3(grid), dim3(512), LDS_BYTES, stream, a); }
    }
}
```

```cpp
#include <hip/hip_runtime.h>
#include <hip/hip_cooperative_groups.h>
#include <cstdio>
#include <cstdint>
namespace cg = cooperative_groups;
namespace pg8 {
#define PG8_LAS __attribute__((address_space(3)))
typedef unsigned short bf16_t;
typedef short bf16x8 __attribute__((ext_vector_type(8)));
typedef float f32x4 __attribute__((ext_vector_type(4)));
typedef unsigned u32x4 __attribute__((ext_vector_type(4)));
constexpr int BM = 256, BK = 64, HALF = 128, HTB = HALF * BK * 2  , STAGE_BYTES = 8 * HTB, NXCD = 8, WGM = 8;

__host__ __device__ __forceinline__ int lds_byte(int r, int c) { const int st = (r >> 4) * 2 + (c >> 5), rr = r & 15, cc = c & 31, ob = rr * 64 + cc * 2; return st * 1024 + (ob ^ (((ob >> 9) & 1) << 5)); }
__host__ __device__ __forceinline__ void stage_rc(int b, int& R, int& C) { const int st = b / 1024, sb = b % 1024, swz = sb ^ (((sb >> 9) & 1) << 5); R = (st >> 1) * 16 + swz / 64; C = (st & 1) * 32 + (swz % 64) / 2; }
__host__ __device__ __forceinline__ int perm32(int rho) { const int n = rho >> 4, i = rho & 15; return 8 * (i >> 2) + 4 * n + (i & 3); }

struct Unit { int pm, pn; };
struct Gemm { const bf16_t* A; const bf16_t* Bt; int M, N, K; };
__device__ __forceinline__ unsigned cvt_pk_bf16(float lo, float hi) { unsigned r; asm volatile("v_cvt_pk_bf16_f32 %0, %1, %2" : "=v"(r) : "v"(lo), "v"(hi)); return r; }
template <class Epi, class Sched, bool ALIGN_EPI = false, bool SP2 = false>
__device__ __forceinline__ void gemm_phase(PG8_LAS unsigned char* lds, const Gemm g, const Sched& S, const Epi& E) {
    const int tid = threadIdx.x, wid = __builtin_amdgcn_readfirstlane(tid >> 6), lane = tid & 63, wr = wid >> 2, wc = wid & 3, fr = lane & 15, fq = lane >> 4;
    const int K = g.K, nt = K / BK;
    unsigned voffA[2], voffB[2];
#pragma unroll
    for (int i = 0; i < 2; ++i) { int R, C; stage_rc(tid * 16 + i * 8192, R, C); const int Rb = Epi::PERM ? ((R & ~31) + perm32(R & 31)) : R;
        voffA[i] = (unsigned)(R * K + C) * 2u; voffB[i] = (unsigned)(Rb * K + C) * 2u; }
    const size_t kstep = (size_t)(BK * 2);
    const size_t hstep = (size_t)HALF * K * 2;
    const size_t tstep = 2 * hstep;
    const unsigned ldsw = (unsigned)wid * 1024u;
    const int aoff = lds_byte(wr * 64 + fr, fq * 8), boff = lds_byte(wc * 32 + fr, fq * 8);
#define PG8_SA(b, h) (((b) * 2 + (h)) * HTB)
#define PG8_SB(b, h) ((4 + (b) * 2 + (h)) * HTB)
#define PG8_STAGE(bufoff, gbase, voff) do { _Pragma("unroll") for (int _i = 0; _i < 2; ++_i) \
        __builtin_amdgcn_global_load_lds((const unsigned*)((const char*)(gbase) + (voff)[_i]), (PG8_LAS unsigned*)(lds + (bufoff) + ldsw + _i * 8192), 16, 0, 0); } while (0)
#define PG8_LDA(dst, b, h) do { _Pragma("unroll") for (int m = 0; m < 4; ++m) _Pragma("unroll") for (int k = 0; k < 2; ++k) dst[m][k] = *(const PG8_LAS bf16x8*)(lds + PG8_SA(b, h) + aoff + m * 2048 + k * 1024); } while (0)
#define PG8_LDB(dst, b, h) do { _Pragma("unroll") for (int n = 0; n < 2; ++n) _Pragma("unroll") for (int k = 0; k < 2; ++k) dst[n][k] = *(const PG8_LAS bf16x8*)(lds + PG8_SB(b, h) + boff + n * 2048 + k * 1024); } while (0)
#define PG8_MMA(ai, bj, At, Bt) do { __builtin_amdgcn_s_setprio(1); _Pragma("unroll") for (int m = 0; m < 4; ++m) _Pragma("unroll") for (int n = 0; n < 2; ++n) _Pragma("unroll") for (int k = 0; k < 2; ++k) \
        acc[ai][bj][m][n] = __builtin_amdgcn_mfma_f32_16x16x32_bf16(Bt[n][k], At[m][k], acc[ai][bj][m][n], 0, 0, 0); __builtin_amdgcn_s_setprio(0); } while (0)
#define PG8_WAIT_V(n) asm volatile("s_waitcnt vmcnt(" #n ")" ::: "memory")
#define PG8_WAIT_L(n) asm volatile("s_waitcnt lgkmcnt(" #n ")" ::: "memory")
#define PG8_BAR __builtin_amdgcn_s_barrier()
#define PG8_SCHED __builtin_amdgcn_sched_barrier(0)
    Unit cur, nxt; int ui = 0;
    if (!S.next(0, cur)) return;
    f32x4 acc[2][2][4][2];
#pragma unroll
    for (int a = 0; a < 2; ++a)
#pragma unroll
        for (int b = 0; b < 2; ++b)
#pragma unroll
            for (int m = 0; m < 4; ++m)
#pragma unroll
                for (int n = 0; n < 2; ++n) acc[a][b][m][n] = (f32x4){0.f, 0.f, 0.f, 0.f};
    bf16x8 At[4][2], B0[2][2], B1[2][2];
    const char* cA = (const char*)g.A + (size_t)cur.pm * tstep; const char* cB = (const char*)g.Bt + (size_t)cur.pn * tstep;
    S.a_ready(cur);
    if constexpr (SP2) {
        PG8_STAGE(PG8_SB(0, 0), cB, voffB); PG8_STAGE(PG8_SB(0, 1), cB + hstep, voffB); PG8_STAGE(PG8_SA(0, 0), cA, voffA); PG8_STAGE(PG8_SA(0, 1), cA + hstep, voffA);
        if (wr == 1) PG8_BAR;
        PG8_WAIT_V(2); PG8_BAR;
        PG8_STAGE(PG8_SB(1, 0), cB + kstep, voffB); PG8_STAGE(PG8_SA(1, 0), cA + kstep, voffA); PG8_STAGE(PG8_SB(1, 1), cB + hstep + kstep, voffB);
        PG8_WAIT_V(6); PG8_BAR;
    } else {
        PG8_STAGE(PG8_SB(0, 0), cB, voffB); PG8_STAGE(PG8_SA(0, 0), cA, voffA); PG8_STAGE(PG8_SB(0, 1), cB + hstep, voffB); PG8_STAGE(PG8_SA(0, 1), cA + hstep, voffA);
        if (wr == 1) PG8_BAR;
        PG8_WAIT_V(4); PG8_BAR;
        PG8_STAGE(PG8_SB(1, 0), cB + kstep, voffB); PG8_STAGE(PG8_SA(1, 0), cA + kstep, voffA); PG8_STAGE(PG8_SB(1, 1), cB + hstep + kstep, voffB);
        PG8_WAIT_V(6); PG8_BAR;
    }
    for (;;) {
        const bool has_next = S.next(ui + 1, nxt);
        const char* nA = has_next ? (const char*)g.A + (size_t)nxt.pm * tstep : cA; const char* nB = has_next ? (const char*)g.Bt + (size_t)nxt.pn * tstep : cB;
        for (int t = 0; t < nt; t += 2) {
            const bool last = (t == nt - 2);
            const char* a1 = cA + (size_t)(t + 1) * kstep;
            const char* a2 = last ? nA : cA + (size_t)(t + 2) * kstep; const char* b2 = last ? nB : cB + (size_t)(t + 2) * kstep;
            const char* a3 = a2 + kstep; const char* b3 = b2 + kstep;
            if (last && has_next) S.a_ready(nxt);
            if constexpr (SP2) {
            PG8_LDB(B0, 0, 0); PG8_LDB(B1, 0, 1); PG8_SCHED; PG8_LDA(At, 0, 0); PG8_STAGE(PG8_SA(1, 1), a1 + hstep, voffA);
            PG8_WAIT_V(8); PG8_WAIT_L(0); PG8_BAR; PG8_MMA(0, 0, At, B0); PG8_MMA(0, 1, At, B1); PG8_BAR; PG8_SCHED;
            PG8_LDA(At, 0, 1); PG8_STAGE(PG8_SB(0, 0), b2, voffB); PG8_STAGE(PG8_SB(0, 1), b2 + hstep, voffB); PG8_STAGE(PG8_SA(0, 0), a2, voffA);
            PG8_WAIT_V(8); PG8_WAIT_L(0); PG8_BAR; PG8_MMA(1, 0, At, B0); PG8_MMA(1, 1, At, B1); PG8_BAR; PG8_SCHED;
            PG8_LDB(B0, 1, 0); PG8_LDB(B1, 1, 1); PG8_SCHED; PG8_LDA(At, 1, 0); PG8_STAGE(PG8_SA(0, 1), a2 + hstep, voffA);
            PG8_WAIT_V(8); PG8_WAIT_L(0); PG8_BAR; PG8_MMA(0, 0, At, B0); PG8_MMA(0, 1, At, B1); PG8_BAR; PG8_SCHED;
            PG8_LDA(At, 1, 1); PG8_STAGE(PG8_SB(1, 0), b3, voffB); PG8_STAGE(PG8_SB(1, 1), b3 + hstep, voffB); PG8_STAGE(PG8_SA(1, 0), a3, voffA);
            PG8_WAIT_V(8); PG8_WAIT_L(0); PG8_BAR; PG8_MMA(1, 0, At, B0); PG8_MMA(1, 1, At, B1); PG8_BAR; PG8_SCHED;
            } else {
            PG8_LDB(B0, 0, 0); PG8_SCHED; PG8_LDA(At, 0, 0); PG8_STAGE(PG8_SA(1, 1), a1 + hstep, voffA);
            PG8_WAIT_L(8); PG8_BAR; PG8_WAIT_L(0); PG8_MMA(0, 0, At, B0); PG8_BAR; PG8_SCHED;
            PG8_LDB(B1, 0, 1); PG8_STAGE(PG8_SB(0, 0), b2, voffB);
            PG8_BAR; PG8_WAIT_L(0); PG8_MMA(0, 1, At, B1); PG8_BAR;
            PG8_LDA(At, 0, 1); PG8_STAGE(PG8_SA(0, 0), a2, voffA);
            PG8_BAR; PG8_WAIT_L(0); PG8_MMA(1, 0, At, B0); PG8_BAR; PG8_SCHED;
            PG8_STAGE(PG8_SB(0, 1), b2 + hstep, voffB);
            PG8_WAIT_V(6); PG8_BAR; PG8_MMA(1, 1, At, B1); PG8_BAR;
            PG8_LDB(B0, 1, 0); PG8_SCHED; PG8_LDA(At, 1, 0); PG8_STAGE(PG8_SA(0, 1), a2 + hstep, voffA);
            PG8_WAIT_L(8); PG8_BAR; PG8_WAIT_L(0); PG8_MMA(0, 0, At, B0); PG8_BAR; PG8_SCHED;
            PG8_LDB(B1, 1, 1); PG8_STAGE(PG8_SB(1, 0), b3, voffB);
            PG8_BAR; PG8_WAIT_L(0); PG8_MMA(0, 1, At, B1); PG8_BAR;
            PG8_LDA(At, 1, 1); PG8_STAGE(PG8_SA(1, 0), a3, voffA);
            PG8_BAR; PG8_WAIT_L(0); PG8_MMA(1, 0, At, B0); PG8_BAR; PG8_SCHED;
            PG8_STAGE(PG8_SB(1, 1), b3 + hstep, voffB);
            PG8_WAIT_V(6); PG8_BAR; PG8_MMA(1, 1, At, B1); PG8_BAR;
            }
        }
        if constexpr (ALIGN_EPI) { if (wr == 0) PG8_BAR; }
        if constexpr (!Epi::AFTER_DRAIN) { E(acc, cur, wr, wc, fr, fq); S.done(cur); }
        if (!has_next) break;
#pragma unroll
        for (int a = 0; a < 2; ++a)
#pragma unroll
            for (int b = 0; b < 2; ++b)
#pragma unroll
                for (int m = 0; m < 4; ++m)
#pragma unroll
                    for (int n = 0; n < 2; ++n) acc[a][b][m][n] = (f32x4){0.f, 0.f, 0.f, 0.f};
        cur = nxt; cA = nA; cB = nB; ++ui;
        if constexpr (ALIGN_EPI) { if (wr == 1) PG8_BAR; }
    }
    PG8_WAIT_V(0);
    if constexpr (!ALIGN_EPI) { if (wr == 0) PG8_BAR; }
    PG8_BAR;
    if constexpr (Epi::AFTER_DRAIN) { E.fused(acc, cur, wr, wc, fr, fq, lds, wid, lane); S.done(cur); }
#undef PG8_SA
#undef PG8_SB
#undef PG8_STAGE
#undef PG8_LDA
#undef PG8_LDB
#undef PG8_MMA
#undef PG8_WAIT_V
#undef PG8_WAIT_L
#undef PG8_BAR
#undef PG8_SCHED
}
}

#define LAS __attribute__((address_space(3)))
typedef unsigned short bf16;
typedef pg8::bf16x8 bf16x8;
typedef pg8::f32x4 f32x4;
typedef pg8::u32x4 u32x4;
typedef float f32x16 __attribute__((ext_vector_type(16)));
typedef unsigned u32x2 __attribute__((ext_vector_type(2)));
using pg8::cvt_pk_bf16;

constexpr int NP = 16384, NS = 128, NROW = NP + NS, MALL = 16640, D = 1024, FF = 4096, TSEQ = 2048;
constexpr int NIN = 2816;
constexpr int PJ = 2048;
constexpr int PJ_Q = 512, PJ_K = 768, PJ_V = 1024, PJ_R = 1536;
constexpr float EPS = 1e-6f;
constexpr int NCHUNK = 32, CH = 64;

constexpr size_t MiB = 1u << 20;
constexpr size_t WS_PART = 1 * MiB;
constexpr size_t PART_BYTES = (size_t)MALL * 16 * 4;
constexpr size_t WS_SPART = 4 * MiB + 512 * 1024, SPART_BYTES = 128 * 32 * 4;
constexpr size_t WS_DEC = 5 * MiB;
constexpr size_t WS_WCAT = 6 * MiB;
constexpr size_t WS_WOUT = 16 * MiB, WS_WXQ = 18 * MiB, WS_WXO = 20 * MiB, WS_WUP = 22 * MiB, WS_WDN = 30 * MiB;
constexpr size_t WS_MKB = 38 * MiB, WS_MVB = 42 * MiB, WS_MVT = 46 * MiB;
constexpr size_t WS_XN = 50 * MiB;
constexpr size_t WS_LA = 87 * MiB;
constexpr size_t WS_X1 = 104 * MiB;
constexpr size_t WS_XB = 169 * MiB;
constexpr size_t WS_QX = 202 * MiB;
constexpr size_t WS_AO = 235 * MiB;
constexpr size_t WS_SB = 268 * MiB;
constexpr size_t WS_PROJ = 284 * MiB;
constexpr size_t WS_MIX = 349 * MiB;
constexpr size_t WS_KV = 382 * MiB;
constexpr size_t WS_HB = 284 * MiB;
constexpr size_t WS_END = 414 * MiB;

constexpr size_t O_YP = 0, O_YS = 16777216, O_CP = 16908288, O_CS = 17031168, O_GP = 18997248, O_GS = 19259392, O_MK = 23453696, O_MV = 25550848;

constexpr int LDS_BYTES = 147456;

__device__ __forceinline__ float bf2f(unsigned short b) { return __uint_as_float(((unsigned)b) << 16); }
__device__ __forceinline__ float bflo(unsigned w) { return __uint_as_float(w << 16); }
__device__ __forceinline__ float bfhi(unsigned w) { return __uint_as_float(w & 0xffff0000u); }
__device__ __forceinline__ unsigned short f2bf(float f) { return (unsigned short)(cvt_pk_bf16(f, 0.f) & 0xffffu); }
__device__ __forceinline__ float sigmoidf_(float x) { return 1.0f / (1.0f + __expf(-x)); }
__device__ __forceinline__ float siluf_(float x) { return x / (1.0f + __expf(-x)); }
__device__ __forceinline__ float wave_sum(float v) {
#pragma unroll
    for (int o = 1; o < 64; o <<= 1) v += __shfl_xor(v, o);
    return v;
}
__device__ __forceinline__ float wave_max(float v) {
#pragma unroll
    for (int o = 1; o < 64; o <<= 1) v = fmaxf(v, __shfl_xor(v, o));
    return v;
}
__device__ __forceinline__ u32x4 pack8(f32x4 a, f32x4 b) { u32x4 w; w.x = cvt_pk_bf16(a[0], a[1]); w.y = cvt_pk_bf16(a[2], a[3]); w.z = cvt_pk_bf16(b[0], b[1]); w.w = cvt_pk_bf16(b[2], b[3]); return w; }
#define LDS_WAIT() asm volatile("s_waitcnt lgkmcnt(0)" ::: "memory")

#define RLX_AGENT __ATOMIC_RELAXED, __HIP_MEMORY_SCOPE_AGENT
#define XB_TMO      128
#define XB_XCNT(j)  (256  + 64 * (j))
#define XB_XSUB(j)  (1280 + 64 * (j))
#define XB_XGEN(j)  (2304 + 64 * (j))
#define XB_TOP      3328
#define XB_TOPGEN   3392
#define XCD_BAR_WORDS 3456
#define XB_SPIN_CAP (1u << 18)

__device__ __forceinline__ unsigned xb_ld(unsigned* p)              { return __hip_atomic_load(p, __ATOMIC_RELAXED, __HIP_MEMORY_SCOPE_AGENT); }
__device__ __forceinline__ unsigned xb_add(unsigned* p, unsigned v) { return __hip_atomic_fetch_add(p, v, __ATOMIC_RELAXED, __HIP_MEMORY_SCOPE_AGENT); }
__device__ __forceinline__ unsigned xb_xcc_id() { return (unsigned)__builtin_amdgcn_s_getreg((3 << 11) | 20) & 0xFu; }
#define XB_SPIN(cond, bar) do { unsigned _sp = 0; while (cond) { __builtin_amdgcn_s_sleep(1); \
    if ((++_sp & 255u) == 0u) { if (xb_ld(&(bar)[XB_TMO])) break; if (_sp > XB_SPIN_CAP) { atomicAdd(&(bar)[XB_TMO], 1u); break; } } } } while (0)

struct XcdBarrier {
    unsigned* bar; unsigned x;
    volatile LAS unsigned* st;
};

__device__ __forceinline__ XcdBarrier xcd_barrier_post(unsigned* bar, volatile LAS unsigned* st) {
    XcdBarrier b; b.bar = bar; b.x = xb_xcc_id(); b.st = st;
    if (threadIdx.x == 0) (void)xb_add(&bar[XB_XCNT(b.x)], 1u);
    return b;
}
__device__ __forceinline__ void xcd_barrier_complete(unsigned* bar, unsigned x, unsigned& nloc, unsigned& nx) {
    const unsigned G = gridDim.x * gridDim.y * gridDim.z;
    unsigned sum, cnt, mine, sp = 0u;
    for (;;) {
        sum = 0u; cnt = 0u; mine = 0u;
#pragma unroll
        for (unsigned j = 0; j < 16; ++j) { const unsigned c = xb_ld(&bar[XB_XCNT(j)]); sum += c; cnt += (c > 0u) ? 1u : 0u; mine = (j == x) ? c : mine; }
        if (sum == G) break;
        __builtin_amdgcn_s_sleep(1);
        if ((++sp & 255u) == 0u) { if (xb_ld(&bar[XB_TMO])) break; if (sp > XB_SPIN_CAP) { atomicAdd(&bar[XB_TMO], 1u); break; } }
    }
    nloc = mine > 0u ? mine : 1u; nx = cnt > 0u ? cnt : 1u;
}

__device__ __forceinline__ void xcd_barrier(const XcdBarrier& b) {
    asm volatile("s_waitcnt vmcnt(0)" ::: "memory");
    __syncthreads();
    if (threadIdx.x == 0) {
        unsigned* bar = b.bar;
        __builtin_amdgcn_s_waitcnt(0);
        unsigned nloc = b.st[0], nx = b.st[1];
        if (nloc == 0u) { xcd_barrier_complete(bar, b.x, nloc, nx); b.st[0] = nloc; b.st[1] = nx; }
        const unsigned old = xb_add(&bar[XB_XSUB(b.x)], 1u);
        const unsigned gen = old / nloc;
        if (old + 1u == (gen + 1u) * nloc) {
            __builtin_amdgcn_fence(__ATOMIC_RELEASE, "agent");
            asm volatile("s_waitcnt vmcnt(0)" ::: "memory");
            const unsigned og = xb_add(&bar[XB_TOP], 1u);
            const unsigned tg = og / nx;
            if (og + 1u == (tg + 1u) * nx) xb_add(&bar[XB_TOPGEN], 1u);
            else XB_SPIN(xb_ld(&bar[XB_TOPGEN]) == tg, bar);
            __builtin_amdgcn_fence(__ATOMIC_ACQUIRE, "agent");
            xb_add(&bar[XB_XGEN(b.x)], 1u);
            asm volatile("s_waitcnt vmcnt(0)" ::: "memory");
        } else {
            XB_SPIN(xb_ld(&bar[XB_XGEN(b.x)]) == gen, bar);
            __builtin_amdgcn_fence(__ATOMIC_ACQUIRE, "agent");
            asm volatile("s_waitcnt vmcnt(0)" ::: "memory");
        }
    }
    __syncthreads();
}


struct Args { const float* in[27]; float* out; unsigned char* ws; int ph_lo, ph_hi; };

struct OrderRect {
    int nM, nN, nwg, G, c, n2M, n2N, pm2, pn2;
    __device__ void init(int nM_, int nN_, int G_, int c_, int n2M_ = 0, int n2N_ = 0, int pm2_ = 0, int pn2_ = 0) { nM = nM_; nN = nN_; nwg = nM * nN; G = G_; c = c_; n2M = n2M_; n2N = n2N_; pm2 = pm2_; pn2 = pn2_; }
    __device__ bool next(int i, pg8::Unit& u) const {
        long L = (long)i * G + c;
        if (L < nwg) {
            int wgid = (int)L; { const int q = nwg / 8, r = nwg % 8, xcd = wgid % 8, off = wgid / 8; wgid = (xcd < r ? xcd * (q + 1) : r * (q + 1) + (xcd - r) * q) + off; }
            const int nig = 8 * nN, gid = wgid / nig, fm = gid * 8, gsz = (nM - fm) < 8 ? (nM - fm) : 8;
            u.pm = fm + ((wgid % nig) % gsz); u.pn = (wgid % nig) / gsz; return true;
        }
        L -= nwg;
        if (L < (long)n2M * n2N) { u.pm = pm2 + (int)(L % n2M); u.pn = pn2 + (int)(L / n2M); return true; }
        return false;
    }
    __device__ __forceinline__ void a_ready(const pg8::Unit&) const {}
    __device__ __forceinline__ void done(const pg8::Unit&) const {}
};

struct EpiG1 {
    static constexpr bool PERM = true, AFTER_DRAIN = false;
    bf16* proj; float* la; const float* b_alpha; float* conv_p; float* conv_s; float* mk_out; float* mv_out; bf16* mkb; bf16* mvb;
    __device__ __forceinline__ void operator()(const f32x4 (&acc)[2][2][4][2], const pg8::Unit& u, int wr, int wc, int fr, int fq) const {
        const int pm = u.pm, pn = u.pn;
        if (pm < 65) {
            if (pn < 4) {
                const int ch = 128 * pn + 32 * wc + 8 * fq;
#pragma unroll
                for (int ai = 0; ai < 2; ++ai) {
                    if (256 * pm + 128 * ai >= NROW) continue;
#pragma unroll
                    for (int m = 0; m < 4; ++m) {
                        const int row = 256 * pm + 128 * ai + 64 * wr + 16 * m + fr;
                        f32x4 u0, u1;
#pragma unroll
                        for (int j = 0; j < 4; ++j) { u0[j] = acc[ai][0][m][0][j] * sigmoidf_(acc[ai][1][m][0][j]); u1[j] = acc[ai][0][m][1][j] * sigmoidf_(acc[ai][1][m][1][j]); }
                        *(u32x4*)(proj + (size_t)row * PJ + ch) = pack8(u0, u1);
                        if (row < NP) { const int t = row & (TSEQ - 1); if (t >= TSEQ - 30) { float* p = conv_p + ((size_t)((row >> 11) * 30 + (t - (TSEQ - 30)))) * 512 + ch; *(f32x4*)p = u0; *(f32x4*)(p + 4) = u1; } }
                        else { float* p = conv_s + ((size_t)((row - NP) * 30 + 29)) * 512 + ch; *(f32x4*)p = u0; *(f32x4*)(p + 4) = u1; }
                    }
                }
            } else if (pn < 10) {
                const bool act = pn >= 8;
#pragma unroll
                for (int ai = 0; ai < 2; ++ai) {
                    if (256 * pm + 128 * ai >= NROW) continue;
#pragma unroll
                    for (int m = 0; m < 4; ++m) {
                        const int row = 256 * pm + 128 * ai + 64 * wr + 16 * m + fr;
#pragma unroll
                        for (int bj = 0; bj < 2; ++bj) {
                            const int col = 512 + 256 * (pn - 4) + 128 * bj + 32 * wc + 8 * fq;
                            f32x4 v0 = acc[ai][bj][m][0], v1 = acc[ai][bj][m][1];
                            if (act) {
#pragma unroll
                                for (int j = 0; j < 4; ++j) { v0[j] = siluf_(v0[j]); v1[j] = siluf_(v1[j]); }
                            }
                            *(u32x4*)(proj + (size_t)row * PJ + col) = pack8(v0, v1);
                        }
                    }
                }
            } else {
#pragma unroll
                for (int bj = 0; bj < 2; ++bj) {
                    const int c = 128 * bj + 32 * wc + 8 * fq;
                    const f32x4 b0 = *(const f32x4*)(b_alpha + c), b1 = *(const f32x4*)(b_alpha + c + 4);
#pragma unroll
                    for (int ai = 0; ai < 2; ++ai) {
                        if (256 * pm + 128 * ai >= NROW) continue;
#pragma unroll
                        for (int m = 0; m < 4; ++m) {
                            const int row = 256 * pm + 128 * ai + 64 * wr + 16 * m + fr;
                            f32x4 z0 = acc[ai][bj][m][0] + b0, z1 = acc[ai][bj][m][1] + b1;
#pragma unroll
                            for (int j = 0; j < 4; ++j) {
                                z0[j] = (fminf(z0[j], 0.f) - __logf(1.0f + __expf(-fabsf(z0[j])))) * 0.0625f;
                                z1[j] = (fminf(z1[j], 0.f) - __logf(1.0f + __expf(-fabsf(z1[j])))) * 0.0625f;
                            }
                            float* p = la + (size_t)row * 256 + c; *(f32x4*)p = z0; *(f32x4*)(p + 4) = z1;
                        }
                    }
                }
            }
        } else {
            const int cb = 256 * (pn - 11);
            const bool isk = cb < 1024;
            float* of = isk ? mk_out : mv_out; bf16* ob = isk ? mkb : mvb; const int c0 = isk ? cb : cb - 1024;
#pragma unroll
            for (int ai = 0; ai < 2; ++ai)
#pragma unroll
                for (int m = 0; m < 4; ++m) {
                    const int row = 256 * (pm - 65) + 128 * ai + 64 * wr + 16 * m + fr;
#pragma unroll
                    for (int bj = 0; bj < 2; ++bj) {
                        const int col = c0 + 128 * bj + 32 * wc + 8 * fq;
                        const f32x4 v0 = acc[ai][bj][m][0], v1 = acc[ai][bj][m][1];
                        float* p = of + (size_t)row * 1024 + col; *(f32x4*)p = v0; *(f32x4*)(p + 4) = v1;
                        *(u32x4*)(ob + (size_t)row * 1024 + col) = pack8(v0, v1);
                    }
                }
        }
    }
};

struct EpiRes {
    static constexpr bool PERM = true, AFTER_DRAIN = false;
    const float* rp; const float* rs; float* op; float* os; bf16* ob; float* part;
    __device__ __forceinline__ void operator()(const f32x4 (&acc)[2][2][4][2], const pg8::Unit& u, int wr, int wc, int fr, int fq) const {
        const int pm = u.pm, pn = u.pn;
#pragma unroll
        for (int ai = 0; ai < 2; ++ai) {
            if (256 * pm + 128 * ai >= NROW) continue;
#pragma unroll
            for (int m = 0; m < 4; ++m) {
                const int row = 256 * pm + 128 * ai + 64 * wr + 16 * m + fr;
                const float* rr = row < NP ? rp + (size_t)row * D : rs + (size_t)(row - NP) * D;
                float* oo = row < NP ? op + (size_t)row * D : os + (size_t)(row - NP) * D;
                float ss = 0.f;
#pragma unroll
                for (int bj = 0; bj < 2; ++bj) {
                    const int col = 256 * pn + 128 * bj + 32 * wc + 8 * fq;
                    const f32x4 x0 = *(const f32x4*)(rr + col) + acc[ai][bj][m][0], x1 = *(const f32x4*)(rr + col + 4) + acc[ai][bj][m][1];
                    *(f32x4*)(oo + col) = x0; *(f32x4*)(oo + col + 4) = x1;
                    if (ob) *(u32x4*)(ob + (size_t)row * D + col) = pack8(x0, x1);
                    ss += (x0[0] * x0[0] + x0[1] * x0[1]) + (x0[2] * x0[2] + x0[3] * x0[3]) + (x1[0] * x1[0] + x1[1] * x1[1]) + (x1[2] * x1[2] + x1[3] * x1[3]);
                }
                ss += __shfl_xor(ss, 16); ss += __shfl_xor(ss, 32);
                if (fq == 0) part[(size_t)row * 16 + pn * 4 + wc] = ss;
            }
        }
    }
};

template <int MODE  > struct EpiScale {
    static constexpr bool PERM = true, AFTER_DRAIN = false;
    const float* part; bf16* o; int ldc;
    __device__ __forceinline__ void operator()(const f32x4 (&acc)[2][2][4][2], const pg8::Unit& u, int wr, int wc, int fr, int fq) const {
        const int pm = u.pm, pn = u.pn;
#pragma unroll
        for (int ai = 0; ai < 2; ++ai) {
            if (256 * pm + 128 * ai >= NROW) continue;
#pragma unroll
            for (int m = 0; m < 4; ++m) {
                const int row = 256 * pm + 128 * ai + 64 * wr + 16 * m + fr;
                const f32x4* pp = (const f32x4*)(part + (size_t)row * 16);
                const f32x4 p0 = pp[0], p1 = pp[1], p2 = pp[2], p3 = pp[3];
                const f32x4 ps = (p0 + p1) + (p2 + p3);
                const float rstd = rsqrtf(((ps[0] + ps[1]) + (ps[2] + ps[3])) * (1.0f / D) + EPS);
#pragma unroll
                for (int bj = 0; bj < 2; ++bj) {
                    const int col = 256 * pn + 128 * bj + 32 * wc + 8 * fq;
                    f32x4 v0 = acc[ai][bj][m][0] * rstd, v1 = acc[ai][bj][m][1] * rstd;
                    if (MODE == 1) {
#pragma unroll
                        for (int j = 0; j < 4; ++j) { const float a = fmaxf(v0[j], 0.f), b = fmaxf(v1[j], 0.f); v0[j] = a * a; v1[j] = b * b; }
                    }
                    *(u32x4*)(o + (size_t)row * ldc + col) = pack8(v0, v1);
                }
            }
        }
    }
};


typedef float f32x4s __attribute__((ext_vector_type(4)));
template <class EpiS>
__device__ __forceinline__ void sgemm_phase(LAS unsigned char* lds, const bf16* A, const bf16* Bt, int K, int nitems, const EpiS& E, int G) {
    int tid_ = threadIdx.x; asm volatile("" : "+v"(tid_)); const int tid = tid_;
    const int lane = tid & 63, w = tid >> 6, fr = lane & 15, fq = lane >> 4, tile = w & 1, kq = w >> 1;
    LAS float* red = (LAS float*)(lds + 131072);
    const int kper = K >> 2;
    for (int item = blockIdx.x; item < nitems; item += G) {
        const int rb = item & 7, cg = item >> 3;
        int c0, c1; E.cols(cg, c0, c1);
        const int cc = tile ? c1 : c0;
        const bf16* ap = A + (size_t)(16 * rb + fr) * K + kq * kper + 8 * fq;
        const bf16* bp = Bt + (size_t)(cc + fr) * K + kq * kper + 8 * fq;
        f32x4 acc = {0.f, 0.f, 0.f, 0.f};
#pragma unroll 8
        for (int s = 0; s < kper / 32; ++s) { const bf16x8 av = *(const bf16x8*)(ap + 32 * s), bv = *(const bf16x8*)(bp + 32 * s); acc = __builtin_amdgcn_mfma_f32_16x16x32_bf16(av, bv, acc, 0, 0, 0); }
        __syncthreads();
#pragma unroll
        for (int i = 0; i < 4; ++i) red[w * 256 + (4 * fq + i) * 16 + fr] = acc[i];
        __syncthreads();
        if (tid < 256) {
            const float v0 = (red[0 * 256 + tid] + red[2 * 256 + tid]) + (red[4 * 256 + tid] + red[6 * 256 + tid]);
            const float v1 = (red[1 * 256 + tid] + red[3 * 256 + tid]) + (red[5 * 256 + tid] + red[7 * 256 + tid]);
            E.apply(16 * rb + (tid >> 4), tid & 15, c0, c1, v0, v1, cg);
        }
    }
}
struct SEpiG1 {
    bf16* proj; float* la; const float* b_alpha; float* conv_s;
    __device__ __forceinline__ void cols(int cg, int& c0, int& c1) const { if (cg < 32) { c0 = 256 * (cg >> 3) + 16 * (cg & 7); c1 = c0 + 128; } else { c0 = 1024 + 32 * (cg - 32); c1 = c0 + 16; } }
    __device__ __forceinline__ void one(int r, int j, float v) const {
        const size_t row = (size_t)(NP + r);
        if (j < 2560) { proj[row * PJ + j - 512] = f2bf(j >= 2048 ? siluf_(v) : v); }
        else { const int cp = j - 2560; const float z = v + b_alpha[cp]; la[row * 256 + cp] = (fminf(z, 0.f) - __logf(1.0f + __expf(-fabsf(z)))) * 0.0625f; }
    }
    __device__ __forceinline__ void apply(int r, int c, int c0, int c1, float v0, float v1, int cg) const {
        if (cg < 32) { const int ch = 128 * (c0 >> 8) + (c0 & 127) + c; const float u = v0 * sigmoidf_(v1); proj[(size_t)(NP + r) * PJ + ch] = f2bf(u); conv_s[(size_t)(r * 30 + 29) * 512 + ch] = u; }
        else { one(r, c0 + c, v0); one(r, c1 + c, v1); }
    }
};
struct SEpiRes {
    const float* rs; float* os; bf16* ob; float* part;
    __device__ __forceinline__ void cols(int cg, int& c0, int& c1) const { c0 = 32 * cg; c1 = c0 + 16; }
    __device__ __forceinline__ void apply(int r, int c, int c0, int c1, float v0, float v1, int cg) const {
        const size_t o0 = (size_t)r * D + c0 + c, o1 = (size_t)r * D + c1 + c;
        const float x0 = rs[o0] + v0, x1 = rs[o1] + v1;
        os[o0] = x0; os[o1] = x1;
        if (ob) { ob[o0] = f2bf(x0); ob[o1] = f2bf(x1); }
        float ss = x0 * x0 + x1 * x1;
        ss += __shfl_xor(ss, 1); ss += __shfl_xor(ss, 2); ss += __shfl_xor(ss, 4); ss += __shfl_xor(ss, 8);
        if (c == 0) part[r * 32 + cg] = ss;
    }
};
template <int MODE> struct SEpiScale {
    const float* part; bf16* o; int ldc;
    __device__ __forceinline__ void cols(int cg, int& c0, int& c1) const { c0 = 32 * cg; c1 = c0 + 16; }
    __device__ __forceinline__ void apply(int r, int c, int c0, int c1, float v0, float v1, int cg) const {
        const f32x4* pp = (const f32x4*)(part + r * 32); f32x4 ps = pp[0];
#pragma unroll
        for (int i = 1; i < 8; ++i) ps = ps + pp[i];
        const float rstd = rsqrtf(((ps[0] + ps[1]) + (ps[2] + ps[3])) * (1.0f / D) + EPS);
        v0 *= rstd; v1 *= rstd;
        if (MODE == 1) { v0 = fmaxf(v0, 0.f); v0 *= v0; v1 = fmaxf(v1, 0.f); v1 *= v1; }
        o[(size_t)r * ldc + c0 + c] = f2bf(v0); o[(size_t)r * ldc + c1 + c] = f2bf(v1);
    }
};

__device__ __forceinline__ void transpose_item(const float* W, int N, int K, bf16* WT, int k0, int n0, int drow0, const float* gk, float sc, LAS float* scr, int lane) {
#pragma unroll 8
    for (int i = 0; i < 32; ++i) { const int kk = 2 * i + (lane >> 5); const float g = gk ? gk[k0 + kk] * sc : sc; scr[kk * 33 + (lane & 31)] = W[(size_t)(k0 + kk) * N + n0 + (lane & 31)] * g; }
    LDS_WAIT(); asm volatile("" ::: "memory");
    const int c = lane & 7;
#pragma unroll
    for (int j = 0; j < 4; ++j) { const int n = (lane >> 3) + 8 * j; const LAS float* s = scr + (8 * c) * 33 + n;
        u32x4 o; o.x = cvt_pk_bf16(s[0 * 33], s[1 * 33]); o.y = cvt_pk_bf16(s[2 * 33], s[3 * 33]); o.z = cvt_pk_bf16(s[4 * 33], s[5 * 33]); o.w = cvt_pk_bf16(s[6 * 33], s[7 * 33]);
        *(u32x4*)(WT + (size_t)(drow0 + n) * K + k0 + 8 * c) = o; }
    LDS_WAIT(); asm volatile("" ::: "memory");
}
__device__ __forceinline__ void norm_row_bf16(const float* xrow, const float* g, bf16* orow, int lane) {
    f32x4 v[4]; float s = 0.f;
#pragma unroll
    for (int j = 0; j < 4; ++j) { v[j] = ((const f32x4*)xrow)[lane + 64 * j]; s += (v[j][0] * v[j][0] + v[j][1] * v[j][1]) + (v[j][2] * v[j][2] + v[j][3] * v[j][3]); }
    const float rstd = rsqrtf(wave_sum(s) * (1.0f / D) + EPS);
#pragma unroll
    for (int j = 0; j < 4; ++j) { const f32x4 gv = ((const f32x4*)g)[lane + 64 * j]; const f32x4 o = v[j] * rstd * gv; u32x2 w; w.x = cvt_pk_bf16(o[0], o[1]); w.y = cvt_pk_bf16(o[2], o[3]); ((u32x2*)orow)[lane + 64 * j] = w; }
}
__device__ __forceinline__ void phase_prep(const Args& a, LAS unsigned char* lds, int G) {
    int tid_ = threadIdx.x; asm volatile("" : "+v"(tid_)); const int tid = tid_, lane = tid & 63, wave = tid >> 6;
    const int gw = blockIdx.x * 8 + wave, NGW = G * 8;
    unsigned char* ws = a.ws;
    LAS float* scr = (LAS float*)(lds + wave * 16384);
    bf16* wcat = (bf16*)(ws + WS_WCAT);
    constexpr int I_IN = 16 * 80, I_SQ = 16 * 32, I_UP = 16 * 128, I_DN = 64 * 32;
    constexpr int NITEMS = I_IN + 5 * I_SQ + I_UP + I_DN;
    for (int it = gw; it < NITEMS; it += NGW) {
        int r = it;
        if (r < I_IN) { const int kb = r / 80, nb = r % 80, n0 = nb * 32; int drow; float sc = 1.f;
            if (n0 < 512) drow = 256 * (n0 >> 7) + (n0 & 127);
            else if (n0 < 1024) { const int c = n0 - 512; drow = 256 * (c >> 7) + 128 + (c & 127); }
            else { drow = n0; if (n0 < 1280) sc = 0.125f; }
            transpose_item(a.in[8], 2576, D, wcat, kb * 64, n0, drow, nullptr, sc, scr, lane); continue; }
        r -= I_IN;
        if (r < I_SQ) { transpose_item(a.in[20], D, D, wcat, (r / 32) * 64, (r % 32) * 32, NIN + (r % 32) * 32, nullptr, 1.f, scr, lane); continue; } r -= I_SQ;
        if (r < I_SQ) { transpose_item(a.in[21], D, D, wcat, (r / 32) * 64, (r % 32) * 32, NIN + 1024 + (r % 32) * 32, nullptr, 1.f, scr, lane); continue; } r -= I_SQ;
        if (r < I_SQ) { transpose_item(a.in[16], D, D, (bf16*)(ws + WS_WOUT), (r / 32) * 64, (r % 32) * 32, (r % 32) * 32, nullptr, 1.f, scr, lane); continue; } r -= I_SQ;
        if (r < I_SQ) { transpose_item(a.in[19], D, D, (bf16*)(ws + WS_WXQ), (r / 32) * 64, (r % 32) * 32, (r % 32) * 32, a.in[17], 0.0625f, scr, lane); continue; } r -= I_SQ;
        if (r < I_SQ) { transpose_item(a.in[22], D, D, (bf16*)(ws + WS_WXO), (r / 32) * 64, (r % 32) * 32, (r % 32) * 32, nullptr, 1.f, scr, lane); continue; } r -= I_SQ;
        if (r < I_UP) { transpose_item(a.in[24], FF, D, (bf16*)(ws + WS_WUP), (r / 128) * 64, (r % 128) * 32, (r % 128) * 32, a.in[23], 1.f, scr, lane); continue; } r -= I_UP;
        transpose_item(a.in[25], D, FF, (bf16*)(ws + WS_WDN), (r / 32) * 64, (r % 32) * 32, (r % 32) * 32, nullptr, 1.f, scr, lane);
    }
    for (int idx = blockIdx.x * 512 + tid; idx < 256 * 1024; idx += G * 512) {
        const int j = idx >> 10, k = idx & 1023; const float* wr = a.in[8] + (size_t)k * 2576 + 2560; float s = 0.f;
#pragma unroll
        for (int r = 0; r < 16; ++r) s += wr[r] * a.in[9][r * 256 + j];
        wcat[(size_t)(2560 + j) * D + k] = f2bf(s);
    }
    bf16* xn = (bf16*)(ws + WS_XN);
    for (int m = gw; m < NROW + 2048; m += NGW) {
        if (m < NP) norm_row_bf16(a.in[0] + (size_t)m * D, a.in[7], xn + (size_t)m * D, lane);
        else if (m < NROW) norm_row_bf16(a.in[1] + (size_t)(m - NP) * D, a.in[7], xn + (size_t)m * D, lane);
        else norm_row_bf16(a.in[6] + (size_t)(m - NROW) * D, a.in[18], xn + (size_t)(MALL + (m - NROW)) * D, lane);
    }
}

__device__ __forceinline__ void conv_prompt_unit(LAS unsigned char* lds, const Args& a, int unit) {
    int tid_ = threadIdx.x; asm volatile("" : "+v"(tid_)); const int tid = tid_, lane = tid & 63, w = tid >> 6;
    const int b = unit >> 6, t0 = (unit & 63) * 32;
    const bf16* proj = (const bf16*)(a.ws + WS_PROJ); bf16* mix = (bf16*)(a.ws + WS_MIX);
    LAS bf16* in = (LAS bf16*)lds; LAS float* y = (LAS float*)(lds + 65536);
    __syncthreads();
#pragma unroll
    for (int it = 0; it < 8; ++it) { const int row = w + 8 * it; if (row < 62) { const int t = t0 - 30 + row; u32x4 v = {0u, 0u, 0u, 0u};
        if (t >= 0) v = *(const u32x4*)(proj + (size_t)(b * TSEQ + t) * PJ + 8 * lane); *(LAS u32x4*)(in + row * 512 + 8 * lane) = v; } }
    const int c = 64 * w + lane;
    float wgt[31];
#pragma unroll
    for (int k = 0; k < 31; ++k) wgt[k] = a.in[11][k * 512 + c];
    const float bias = a.in[12][c];
    __syncthreads();
    for (int tq = 0; tq < 8; ++tq) {
        float x[34];
#pragma unroll
        for (int k = 0; k < 34; ++k) x[k] = bf2f(in[(4 * tq + k) * 512 + c]);
        float a0 = bias, a1 = bias, a2 = bias, a3 = bias;
#pragma unroll
        for (int k = 0; k < 31; ++k) { a0 += wgt[k] * x[k]; a1 += wgt[k] * x[k + 1]; a2 += wgt[k] * x[k + 2]; a3 += wgt[k] * x[k + 3]; }
        y[(4 * tq + 0) * 512 + c] = a0; y[(4 * tq + 1) * 512 + c] = a1; y[(4 * tq + 2) * 512 + c] = a2; y[(4 * tq + 3) * 512 + c] = a3;
    }
    __syncthreads();
    const f32x4 g0 = *(const f32x4*)(a.in[13] + 8 * lane), g1 = *(const f32x4*)(a.in[13] + 8 * lane + 4), b0 = *(const f32x4*)(a.in[14] + 8 * lane), b1 = *(const f32x4*)(a.in[14] + 8 * lane + 4);
#pragma unroll
    for (int k = 0; k < 4; ++k) {
        const int t = w + 8 * k;
        f32x4 v0 = *(LAS f32x4*)(y + t * 512 + 8 * lane), v1 = *(LAS f32x4*)(y + t * 512 + 8 * lane + 4);
        const float mean = wave_sum((v0[0] + v0[1]) + (v0[2] + v0[3]) + (v1[0] + v1[1]) + (v1[2] + v1[3])) * (1.0f / 512.0f);
        v0 = v0 - mean; v1 = v1 - mean;
        const float var = wave_sum((v0[0] * v0[0] + v0[1] * v0[1]) + (v0[2] * v0[2] + v0[3] * v0[3]) + (v1[0] * v1[0] + v1[1] * v1[1]) + (v1[2] * v1[2] + v1[3] * v1[3])) * (1.0f / 512.0f);
        const float rstd = rsqrtf(var + EPS);
        v0 = v0 * rstd * g0 + b0; v1 = v1 * rstd * g1 + b1;
#pragma unroll
        for (int j = 0; j < 4; ++j) { v0[j] = siluf_(v0[j]); v1[j] = siluf_(v1[j]); }
        *(u32x4*)(mix + (size_t)(b * TSEQ + t0 + t) * D + 8 * lane) = pack8(v0, v1);
    }
}
__device__ __forceinline__ void conv_sample_unit(LAS unsigned char* lds, const Args& a, int b) {
    int tid_ = threadIdx.x; asm volatile("" : "+v"(tid_)); const int tid = tid_, lane = tid & 63, w = tid >> 6, c = tid;
    const bf16* proj = (const bf16*)(a.ws + WS_PROJ); bf16* mix = (bf16*)(a.ws + WS_MIX);
    LAS float* red = (LAS float*)lds;
    float* cs = a.out + O_CS;
    __syncthreads();
    float acc = a.in[12][c];
#pragma unroll 6
    for (int k = 0; k < 30; ++k) { const float v = a.in[2][(size_t)(b * 30 + k) * 512 + c]; acc += a.in[11][k * 512 + c] * v; if (k >= 1) cs[(size_t)(b * 30 + k - 1) * 512 + c] = v; }
    acc += a.in[11][30 * 512 + c] * bf2f(proj[(size_t)(NP + b) * PJ + c]);
    float s = wave_sum(acc); if (lane == 0) red[w] = s;
    __syncthreads();
    float mean = 0.f;
#pragma unroll
    for (int i = 0; i < 8; ++i) mean += red[i];
    mean *= (1.0f / 512.0f);
    const float dv = acc - mean;
    s = wave_sum(dv * dv); if (lane == 0) red[8 + w] = s;
    __syncthreads();
    float var = 0.f;
#pragma unroll
    for (int i = 0; i < 8; ++i) var += red[8 + i];
    const float o = dv * rsqrtf(var * (1.0f / 512.0f) + EPS) * a.in[13][c] + a.in[14][c];
    mix[(size_t)(NP + b) * D + c] = f2bf(siluf_(o));
}
__device__ __forceinline__ void gla1_unit(LAS unsigned char* lds, const Args& a, int unit) {
    int tid_ = threadIdx.x; asm volatile("" : "+v"(tid_)); const int tid = tid_, lane = tid & 63, w = tid >> 6;
    const int bh = unit >> 5, n = unit & 31, b = bh >> 2, h = bh & 3, r0 = b * TSEQ + n * CH;
    const bf16* proj = (const bf16*)(a.ws + WS_PROJ); float* la = (float*)(a.ws + WS_LA); float* kv = (float*)(a.ws + WS_KV); float* dec = (float*)(a.ws + WS_DEC);
    LAS unsigned char* kT = lds; LAS unsigned char* vT = lds + 9216; LAS float* segtot = (LAS float*)(lds + 27648);
    const int d = tid & 63, seg = w;
    __syncthreads();
    float c[8]; float run = 0.f;
#pragma unroll
    for (int j = 0; j < 8; ++j) { run += la[(size_t)(r0 + 8 * seg + j) * 256 + h * 64 + d]; c[j] = run; }
    segtot[seg * 64 + d] = run;
    { const int dv = tid & 127, s4 = tid >> 7; unsigned pk[8];
#pragma unroll
        for (int jj = 0; jj < 8; ++jj) { const unsigned lo = proj[(size_t)(r0 + 16 * s4 + 2 * jj) * PJ + PJ_V + h * 128 + dv], hi = proj[(size_t)(r0 + 16 * s4 + 2 * jj + 1) * PJ + PJ_V + h * 128 + dv]; pk[jj] = lo | (hi << 16); }
        *(LAS u32x4*)(vT + dv * 144 + s4 * 32) = (u32x4){pk[0], pk[1], pk[2], pk[3]}; *(LAS u32x4*)(vT + dv * 144 + s4 * 32 + 16) = (u32x4){pk[4], pk[5], pk[6], pk[7]}; }
    __syncthreads();
    float off = 0.f, tot = 0.f;
#pragma unroll
    for (int s = 0; s < 8; ++s) { const float t = segtot[s * 64 + d]; tot += t; if (s < seg) off += t; }
    float kin[8];
#pragma unroll
    for (int j = 0; j < 8; ++j) { const float bj = c[j] + off; la[(size_t)(r0 + 8 * seg + j) * 256 + h * 64 + d] = bj;
        kin[j] = bf2f(proj[(size_t)(r0 + 8 * seg + j) * PJ + PJ_K + h * 64 + d]) * __expf(tot - bj); }
    *(LAS u32x4*)(kT + d * 144 + seg * 16) = (u32x4){cvt_pk_bf16(kin[0], kin[1]), cvt_pk_bf16(kin[2], kin[3]), cvt_pk_bf16(kin[4], kin[5]), cvt_pk_bf16(kin[6], kin[7])};
    if (seg == 0) dec[(size_t)(bh * NCHUNK + n) * 64 + d] = __expf(tot);
    __syncthreads();
    const int mb = w >> 2, nb = w & 3, nn = lane & 31, g = lane >> 5;
    f32x16 acc;
#pragma unroll
    for (int i = 0; i < 16; ++i) acc[i] = 0.f;
#pragma unroll
    for (int s = 0; s < 4; ++s) { const bf16x8 af = *(LAS bf16x8*)(kT + (32 * mb + nn) * 144 + (16 * s + 8 * g) * 2), bfv = *(LAS bf16x8*)(vT + (32 * nb + nn) * 144 + (16 * s + 8 * g) * 2);
        acc = __builtin_amdgcn_mfma_f32_32x32x16_bf16(af, bfv, acc, 0, 0, 0); }
#pragma unroll
    for (int i = 0; i < 16; ++i) { const int dd = 32 * mb + 8 * (i >> 2) + 4 * g + (i & 3); kv[((size_t)(bh * NCHUNK + n) * 64 + dd) * 128 + 32 * nb + nn] = acc[i]; }
}
__device__ __forceinline__ void gla_sample_unit(LAS unsigned char* lds, const Args& a, int unit) {
    int tid_ = threadIdx.x; asm volatile("" : "+v"(tid_)); const int tid = tid_, lane = tid & 63, w = tid >> 6;
    const int b = unit >> 2, h = unit & 3, row = NP + b;
    const bf16* proj = (const bf16*)(a.ws + WS_PROJ); const float* la = (const float*)(a.ws + WS_LA); bf16* mix = (bf16*)(a.ws + WS_MIX);
    LAS float* red = (LAS float*)lds;
    LAS float* red2 = red + 2048;
    const int dv = 4 * (tid & 31), dg = tid >> 5;
    __syncthreads();
    const u32x2 vv = *(const u32x2*)(proj + (size_t)row * PJ + PJ_V + h * 128 + dv);
    const f32x4 v4 = {bflo(vv.x), bfhi(vv.x), bflo(vv.y), bfhi(vv.y)};
    f32x4 o4 = {0.f, 0.f, 0.f, 0.f};
#pragma unroll
    for (int dd = 0; dd < 4; ++dd) { const int d = 4 * dg + dd;
        const float al = __expf(la[(size_t)row * 256 + h * 64 + d]), kk = bf2f(proj[(size_t)row * PJ + PJ_K + h * 64 + d]), qq = bf2f(proj[(size_t)row * PJ + PJ_Q + h * 64 + d]);
        const size_t so = ((size_t)(b * 4 + h) * 64 + d) * 128 + dv;
        const f32x4 sn = *(const f32x4*)(a.in[3] + so) * al + v4 * kk;
        *(f32x4*)(a.out + O_GS + so) = sn; o4 = o4 + sn * qq; }
    *(LAS f32x4*)(red + dg * 128 + dv) = o4;
    __syncthreads();
    float o = 0.f;
    if (tid < 128) {
#pragma unroll
        for (int i = 0; i < 16; ++i) o += red[i * 128 + tid];
        const float ss = wave_sum(o * o); if (lane == 0) red2[w] = ss;
    }
    __syncthreads();
    if (tid < 128) { const float rstd = rsqrtf((red2[0] + red2[1]) * (1.0f / 128.0f) + EPS);
        mix[(size_t)row * D + 512 + h * 128 + tid] = f2bf(o * rstd * a.in[15][tid] * bf2f(proj[(size_t)row * PJ + PJ_R + h * 128 + tid])); }
}
__device__ __forceinline__ void vt_unit(const Args& a, int unit) {
    int tid_ = threadIdx.x; asm volatile("" : "+v"(tid_)); const int tid = tid_, b = unit >> 2, h = unit & 3, hd = tid & 255, ms = tid >> 8;
    const bf16* mvb = (const bf16*)(a.ws + WS_MVB); bf16* mvt = (bf16*)(a.ws + WS_MVT);
    for (int mc = 0; mc < 16; ++mc) { const int m0 = ms * 128 + mc * 8; unsigned pk[4];
#pragma unroll
        for (int j = 0; j < 4; ++j) { const unsigned lo = mvb[(size_t)(b * 256 + m0 + 2 * j) * D + h * 256 + hd], hi = mvb[(size_t)(b * 256 + m0 + 2 * j + 1) * D + h * 256 + hd]; pk[j] = lo | (hi << 16); }
        *(u32x4*)(mvt + ((size_t)(b * 4 + h) * 256 + hd) * 256 + m0) = (u32x4){pk[0], pk[1], pk[2], pk[3]}; }
}

__device__ __forceinline__ void phase_scan(const Args& a, int G) {
    const float* kv = (const float*)(a.ws + WS_KV); const float* dec = (const float*)(a.ws + WS_DEC); bf16* sb = (bf16*)(a.ws + WS_SB);
    typedef float f32x2 __attribute__((ext_vector_type(2)));
    for (int p = blockIdx.x * 512 + threadIdx.x; p < 32 * 4096; p += G * 512) {
        const int bh = p >> 12, e = (p & 4095) * 2, d = e >> 7;
        f32x2 S = {0.f, 0.f};
#pragma unroll 8
        for (int n = 0; n < NCHUNK; ++n) {
            const size_t o = (size_t)(bh * NCHUNK + n) * 8192 + e;
            const f32x2 k2 = *(const f32x2*)(kv + o); const float dc = dec[(size_t)(bh * NCHUNK + n) * 64 + d];
            *(unsigned*)(sb + o) = cvt_pk_bf16(S[0], S[1]);
            S = S * dc + k2;
        }
        *(f32x2*)(a.out + O_GP + (size_t)bh * 8192 + e) = S;
    }
}

__device__ __forceinline__ void gla3_unit(LAS unsigned char* lds, const Args& a, int unit) {
    int tid_ = threadIdx.x; asm volatile("" : "+v"(tid_)); const int tid = tid_, lane = tid & 63, w = tid >> 6;
    const int bh = unit >> 5, n = unit & 31, b = bh >> 2, h = bh & 3, r0 = b * TSEQ + n * CH;
    const bf16* proj = (const bf16*)(a.ws + WS_PROJ); const float* la = (const float*)(a.ws + WS_LA); const bf16* sb = (const bf16*)(a.ws + WS_SB); bf16* mix = (bf16*)(a.ws + WS_MIX);
    LAS unsigned char* vT = lds; LAS unsigned char* sT = lds + 18432; LAS unsigned char* P = lds + 36864; LAS unsigned char* qin = lds + 46080; LAS unsigned char* kt = lds + 55296;
    LAS float* O = (LAS float*)(lds + 64512);
    __syncthreads();
    { const int d = tid & 63, seg = w;
#pragma unroll
        for (int j = 0; j < 8; ++j) { const int t = 8 * seg + j; const float bb = la[(size_t)(r0 + t) * 256 + h * 64 + d];
            const float q = bf2f(proj[(size_t)(r0 + t) * PJ + PJ_Q + h * 64 + d]), k = bf2f(proj[(size_t)(r0 + t) * PJ + PJ_K + h * 64 + d]);
            *(LAS bf16*)(qin + t * 144 + d * 2) = f2bf(q * __expf(bb)); *(LAS bf16*)(kt + t * 144 + d * 2) = f2bf(k * __expf(-bb)); } }
    { const int dv = tid & 127, s4 = tid >> 7; unsigned pk[8];
#pragma unroll
        for (int jj = 0; jj < 8; ++jj) { const unsigned lo = proj[(size_t)(r0 + 16 * s4 + 2 * jj) * PJ + PJ_V + h * 128 + dv], hi = proj[(size_t)(r0 + 16 * s4 + 2 * jj + 1) * PJ + PJ_V + h * 128 + dv]; pk[jj] = lo | (hi << 16); }
        *(LAS u32x4*)(vT + dv * 144 + s4 * 32) = (u32x4){pk[0], pk[1], pk[2], pk[3]}; *(LAS u32x4*)(vT + dv * 144 + s4 * 32 + 16) = (u32x4){pk[4], pk[5], pk[6], pk[7]};
        const bf16* sp = sb + (size_t)(bh * NCHUNK + n) * 8192;
#pragma unroll
        for (int jj = 0; jj < 8; ++jj) { const unsigned lo = sp[(16 * s4 + 2 * jj) * 128 + dv], hi = sp[(16 * s4 + 2 * jj + 1) * 128 + dv]; pk[jj] = lo | (hi << 16); }
        *(LAS u32x4*)(sT + dv * 144 + s4 * 32) = (u32x4){pk[0], pk[1], pk[2], pk[3]}; *(LAS u32x4*)(sT + dv * 144 + s4 * 32 + 16) = (u32x4){pk[4], pk[5], pk[6], pk[7]}; }
    __syncthreads();
    const int nn = lane & 31, g = lane >> 5;
    if (w < 4) { const int ib = w >> 1, jb = w & 1;
        f32x16 acc;
#pragma unroll
        for (int i = 0; i < 16; ++i) acc[i] = 0.f;
#pragma unroll
        for (int s = 0; s < 4; ++s) { const bf16x8 af = *(LAS bf16x8*)(qin + (32 * ib + nn) * 144 + (16 * s + 8 * g) * 2), bfv = *(LAS bf16x8*)(kt + (32 * jb + nn) * 144 + (16 * s + 8 * g) * 2);
            acc = __builtin_amdgcn_mfma_f32_32x32x16_bf16(af, bfv, acc, 0, 0, 0); }
#pragma unroll
        for (int i = 0; i < 16; ++i) { const int ii = 32 * ib + 8 * (i >> 2) + 4 * g + (i & 3), jj = 32 * jb + nn; *(LAS bf16*)(P + ii * 144 + jj * 2) = f2bf(jj <= ii ? acc[i] : 0.f); } }
    __syncthreads();
    { const int ib = w >> 2, nb = w & 3;
        f32x16 acc;
#pragma unroll
        for (int i = 0; i < 16; ++i) acc[i] = 0.f;
#pragma unroll
        for (int s = 0; s < 4; ++s) { const bf16x8 af = *(LAS bf16x8*)(P + (32 * ib + nn) * 144 + (16 * s + 8 * g) * 2), bfv = *(LAS bf16x8*)(vT + (32 * nb + nn) * 144 + (16 * s + 8 * g) * 2);
            acc = __builtin_amdgcn_mfma_f32_32x32x16_bf16(af, bfv, acc, 0, 0, 0); }
#pragma unroll
        for (int s = 0; s < 4; ++s) { const bf16x8 af = *(LAS bf16x8*)(qin + (32 * ib + nn) * 144 + (16 * s + 8 * g) * 2), bfv = *(LAS bf16x8*)(sT + (32 * nb + nn) * 144 + (16 * s + 8 * g) * 2);
            acc = __builtin_amdgcn_mfma_f32_32x32x16_bf16(af, bfv, acc, 0, 0, 0); }
#pragma unroll
        for (int i = 0; i < 16; ++i) { const int ii = 32 * ib + 8 * (i >> 2) + 4 * g + (i & 3); O[ii * 132 + 32 * nb + nn] = acc[i]; } }
    __syncthreads();
    { const int i = tid >> 3, part = tid & 7; f32x4 o[4]; float ss = 0.f;
#pragma unroll
        for (int j = 0; j < 4; ++j) { o[j] = *(LAS f32x4*)(O + i * 132 + 16 * part + 4 * j); ss += (o[j][0] * o[j][0] + o[j][1] * o[j][1]) + (o[j][2] * o[j][2] + o[j][3] * o[j][3]); }
        ss += __shfl_xor(ss, 1); ss += __shfl_xor(ss, 2); ss += __shfl_xor(ss, 4);
        const float rstd = rsqrtf(ss * (1.0f / 128.0f) + EPS);
        const size_t row = (size_t)(r0 + i);
        const u32x4 r0v = *(const u32x4*)(proj + row * PJ + PJ_R + h * 128 + 16 * part), r1v = *(const u32x4*)(proj + row * PJ + PJ_R + h * 128 + 16 * part + 8);
        const float* gg = a.in[15] + 16 * part;
        const unsigned rw[8] = {r0v.x, r0v.y, r0v.z, r0v.w, r1v.x, r1v.y, r1v.z, r1v.w};
        unsigned ow[8];
#pragma unroll
        for (int j = 0; j < 8; ++j) { const float x0 = o[j >> 1][(j & 1) * 2] * rstd * gg[2 * j] * bflo(rw[j]), x1 = o[j >> 1][(j & 1) * 2 + 1] * rstd * gg[2 * j + 1] * bfhi(rw[j]); ow[j] = cvt_pk_bf16(x0, x1); }
        bf16* op = mix + row * D + 512 + h * 128 + 16 * part;
        *(u32x4*)op = (u32x4){ow[0], ow[1], ow[2], ow[3]}; *(u32x4*)(op + 8) = (u32x4){ow[4], ow[5], ow[6], ow[7]}; }
}

__device__ __forceinline__ void attn_prompt_unit(LAS unsigned char* lds, const Args& a, int unit) {
    int tid_ = threadIdx.x; asm volatile("" : "+v"(tid_)); const int tid = tid_, lane = tid & 63, w = tid >> 6, nn = lane & 31, g = lane >> 5;
    const int b = unit >> 5, h = (unit >> 3) & 3, qt = unit & 7;
    const bf16* qx = (const bf16*)(a.ws + WS_QX); const bf16* mkb = (const bf16*)(a.ws + WS_MKB); const bf16* mvt = (const bf16*)(a.ws + WS_MVT); bf16* ao = (bf16*)(a.ws + WS_AO);
    const size_t qrow = (size_t)b * TSEQ + qt * 256 + 32 * w + nn;
    __syncthreads();
#pragma unroll 4
    for (int it = 0; it < 16; ++it) { const int row = (tid >> 5) + 16 * it, ch = tid & 31;
        *(LAS u32x4*)(lds + row * 528 + ch * 16) = *(const u32x4*)(mkb + (size_t)(b * 256 + row) * D + h * 256 + ch * 8); }
    bf16x8 qf[16];
#pragma unroll
    for (int s = 0; s < 16; ++s) qf[s] = *(const bf16x8*)(qx + qrow * D + h * 256 + 16 * s + 8 * g);
    __syncthreads();
    f32x16 acc[8];
#pragma unroll
    for (int kb = 0; kb < 8; ++kb) {
#pragma unroll
        for (int i = 0; i < 16; ++i) acc[kb][i] = 0.f;
#pragma unroll
        for (int s = 0; s < 16; ++s) { const bf16x8 af = *(LAS bf16x8*)(lds + (32 * kb + nn) * 528 + (16 * s + 8 * g) * 2); acc[kb] = __builtin_amdgcn_mfma_f32_32x32x16_bf16(af, qf[s], acc[kb], 0, 0, 0); }
    }
    float mx = -3.0e38f;
#pragma unroll
    for (int kb = 0; kb < 8; ++kb)
#pragma unroll
        for (int i = 0; i < 16; ++i) mx = fmaxf(mx, acc[kb][i]);
    mx = fmaxf(mx, __shfl_xor(mx, 32));
    float sum = 0.f;
    u32x4 pb[8][2];
#pragma unroll
    for (int kb = 0; kb < 8; ++kb) {
#pragma unroll
        for (int i = 0; i < 16; ++i) { const float p = __expf(acc[kb][i] - mx); sum += p; acc[kb][i] = p; }
#pragma unroll
        for (int hh = 0; hh < 2; ++hh) { pb[kb][hh].x = cvt_pk_bf16(acc[kb][8 * hh + 0], acc[kb][8 * hh + 1]); pb[kb][hh].y = cvt_pk_bf16(acc[kb][8 * hh + 2], acc[kb][8 * hh + 3]);
            pb[kb][hh].z = cvt_pk_bf16(acc[kb][8 * hh + 4], acc[kb][8 * hh + 5]); pb[kb][hh].w = cvt_pk_bf16(acc[kb][8 * hh + 6], acc[kb][8 * hh + 7]); }
    }
    sum += __shfl_xor(sum, 32);
    const float inv = 1.0f / sum;
    __syncthreads();
#pragma unroll 4
    for (int it = 0; it < 16; ++it) { const int row = (tid >> 5) + 16 * it, ch = tid & 31;
        *(LAS u32x4*)(lds + row * 528 + ch * 16) = *(const u32x4*)(mvt + ((size_t)(b * 4 + h) * 256 + row) * 256 + ch * 8); }
    __syncthreads();
#pragma unroll
    for (int mb = 0; mb < 8; ++mb) {
        f32x16 o;
#pragma unroll
        for (int i = 0; i < 16; ++i) o[i] = 0.f;
#pragma unroll
        for (int kb = 0; kb < 8; ++kb)
#pragma unroll
            for (int hh = 0; hh < 2; ++hh) { const int base = 32 * kb + 16 * hh;
                const u32x2 lo = *(LAS u32x2*)(lds + (32 * mb + nn) * 528 + (base + 4 * g) * 2), hi = *(LAS u32x2*)(lds + (32 * mb + nn) * 528 + (base + 8 + 4 * g) * 2);
                const u32x4 av = {lo.x, lo.y, hi.x, hi.y};
                o = __builtin_amdgcn_mfma_f32_32x32x16_bf16(__builtin_bit_cast(bf16x8, av), __builtin_bit_cast(bf16x8, pb[kb][hh]), o, 0, 0, 0); }
#pragma unroll
        for (int i4 = 0; i4 < 4; ++i4) { u32x2 wv; wv.x = cvt_pk_bf16(o[4 * i4] * inv, o[4 * i4 + 1] * inv); wv.y = cvt_pk_bf16(o[4 * i4 + 2] * inv, o[4 * i4 + 3] * inv);
            *(u32x2*)(ao + qrow * D + h * 256 + 32 * mb + 8 * i4 + 4 * g) = wv; }
    }
}
__device__ __forceinline__ void attn_sample_unit(LAS unsigned char* lds, const Args& a, int unit) {
    int tid_ = threadIdx.x; asm volatile("" : "+v"(tid_)); const int tid = tid_, lane = tid & 63, w = tid >> 6;
    const int b = unit >> 2, h = unit & 3;
    const bf16* qx = (const bf16*)(a.ws + WS_QX); bf16* ao = (bf16*)(a.ws + WS_AO);
    LAS float* sc = (LAS float*)lds; LAS float* red = sc + 256;
    const u32x2 qq = *(const u32x2*)(qx + (size_t)(NP + b) * D + h * 256 + 4 * lane);
    const f32x4 q4 = {bflo(qq.x), bfhi(qq.x), bflo(qq.y), bfhi(qq.y)};
    const float* kbase = a.in[4] + ((size_t)b * 256 * 4 + h) * 256 + 4 * lane;
    const float* vbase = a.in[5] + ((size_t)b * 256 * 4 + h) * 256 + 4 * lane;
    __syncthreads();
#pragma unroll 1
    for (int c = 0; c < 4; ++c) {
        f32x4 kv[8];
#pragma unroll
        for (int j = 0; j < 8; ++j) kv[j] = *(const f32x4*)(kbase + (size_t)(32 * w + 8 * c + j) * 1024);
#pragma unroll
        for (int j = 0; j < 8; ++j) { const float dsum = wave_sum((kv[j][0] * q4[0] + kv[j][1] * q4[1]) + (kv[j][2] * q4[2] + kv[j][3] * q4[3])); if (lane == j) sc[32 * w + 8 * c + j] = dsum; }
    }
    __syncthreads();
    const float s0 = sc[lane], s1 = sc[64 + lane], s2 = sc[128 + lane], s3 = sc[192 + lane];
    const float mx = wave_max(fmaxf(fmaxf(s0, s1), fmaxf(s2, s3)));
    const float inv = 1.0f / wave_sum((__expf(s0 - mx) + __expf(s1 - mx)) + (__expf(s2 - mx) + __expf(s3 - mx)));
    f32x4 o4 = {0.f, 0.f, 0.f, 0.f};
#pragma unroll 1
    for (int c = 0; c < 4; ++c) {
        f32x4 vv[8];
#pragma unroll
        for (int j = 0; j < 8; ++j) vv[j] = *(const f32x4*)(vbase + (size_t)(32 * w + 8 * c + j) * 1024);
#pragma unroll
        for (int j = 0; j < 8; ++j) { const float p = __expf(sc[32 * w + 8 * c + j] - mx) * inv; o4 = o4 + vv[j] * p; }
    }
    *(LAS f32x4*)(red + w * 256 + 4 * lane) = o4;
    __syncthreads();
    if (tid < 256) { float o = 0.f;
#pragma unroll
        for (int i = 0; i < 8; ++i) o += red[i * 256 + tid];
        ao[(size_t)(NP + b) * D + h * 256 + tid] = f2bf(o); }
}

__device__ __forceinline__ void phase_final(const Args& a, int G) {
    int tid_ = threadIdx.x; asm volatile("" : "+v"(tid_)); const int tid = tid_, lane = tid & 63, wave = tid >> 6;
    const float* part = (const float*)(a.ws + WS_PART + 2 * PART_BYTES); const float* spart = (const float*)(a.ws + WS_SPART + 2 * SPART_BYTES);
    for (int m = blockIdx.x * 8 + wave; m < NROW; m += G * 8) {
        float* y = a.out + (m < NP ? O_YP + (size_t)m * D : O_YS + (size_t)(m - NP) * D);
        const float pv = m < NP ? (lane < 16 ? part[(size_t)m * 16 + lane] : 0.f) : (lane < 32 ? spart[(size_t)(m - NP) * 32 + lane] : 0.f);
        const float rstd = rsqrtf(wave_sum(pv) * (1.0f / D) + EPS);
#pragma unroll
        for (int j = 0; j < 4; ++j) { const f32x4 gv = ((const f32x4*)a.in[26])[lane + 64 * j]; f32x4 v = ((f32x4*)y)[lane + 64 * j]; ((f32x4*)y)[lane + 64 * j] = v * rstd * gv; }
    }
}

__global__ void __launch_bounds__(512, 2) hybrid_fwd(Args a) {
    extern __shared__ __attribute__((aligned(16))) unsigned char lds_raw[];
    LAS unsigned char* lds = (LAS unsigned char*)lds_raw;
    cg::grid_group grid = cg::this_grid();
    const int G = gridDim.x, bx = blockIdx.x;
    unsigned char* ws = a.ws;
    const int lo = a.ph_lo, hi = a.ph_hi;
    volatile LAS unsigned* bst = (volatile LAS unsigned*)(lds + LDS_BYTES - 64);
    if (threadIdx.x < 2) bst[threadIdx.x] = 0u;
    __syncthreads();
    XcdBarrier bar = xcd_barrier_post((unsigned*)ws, bst);
    if (lo < 0) grid.sync();
#define IN(k) (lo <= (k) && (k) < hi)
#define SEAM(k) do { if (IN(k) && IN((k) + 1)) xcd_barrier(bar); } while (0)

    if (IN(0)) phase_prep(a, lds, G);
    SEAM(0);
    if (IN(1)) {
        __syncthreads();
        { SEpiG1 SE{(bf16*)(ws + WS_PROJ), (float*)(ws + WS_LA), a.in[10], a.out + O_CS};
          sgemm_phase(lds, (const bf16*)(ws + WS_XN) + (size_t)NP * D, (const bf16*)(ws + WS_WCAT), D, 8 * 88, SE, G); }
        pg8::Gemm g{(const bf16*)(ws + WS_XN), (const bf16*)(ws + WS_WCAT), 0, 0, D}; OrderRect S; S.init(64, 11, G, bx, 8, 8, 65, 11);
        EpiG1 E{(bf16*)(ws + WS_PROJ), (float*)(ws + WS_LA), a.in[10], a.out + O_CP, a.out + O_CS, a.out + O_MK, a.out + O_MV, (bf16*)(ws + WS_MKB), (bf16*)(ws + WS_MVB)};
        pg8::gemm_phase<EpiG1, OrderRect, true, true>(lds, g, S, E);
    }
    SEAM(1);
    if (IN(2)) {
        constexpr int U_CONV = 512, U_G1 = 1024, U_CS = 128, U_GS = 512, U_VT = 32, U_ALL = U_CONV + U_G1 + U_CS + U_GS + U_VT;
        for (int u = bx; u < U_ALL; u += G) {
            int r = u;
            if (r < U_G1) { gla1_unit(lds, a, r); continue; } r -= U_G1;
            if (r < U_CONV) { conv_prompt_unit(lds, a, r); continue; } r -= U_CONV;
            if (r < U_GS) { gla_sample_unit(lds, a, r); continue; } r -= U_GS;
            if (r < U_CS) { conv_sample_unit(lds, a, r); continue; } r -= U_CS;
            vt_unit(a, r);
        }
    }
    SEAM(2);
    if (IN(3)) phase_scan(a, G);
    SEAM(3);
    if (IN(4)) { for (int u = bx; u < 1024; u += G) gla3_unit(lds, a, u); }
    SEAM(4);
    if (IN(5)) {
        __syncthreads();
        { SEpiRes SE{a.in[1], (float*)(ws + WS_X1) + (size_t)NP * D, (bf16*)(ws + WS_XB) + (size_t)NP * D, (float*)(ws + WS_SPART)};
          sgemm_phase(lds, (const bf16*)(ws + WS_MIX) + (size_t)NP * D, (const bf16*)(ws + WS_WOUT), D, 8 * 32, SE, G); }
        pg8::Gemm g{(const bf16*)(ws + WS_MIX), (const bf16*)(ws + WS_WOUT), 0, 0, D}; OrderRect S; S.init(64, 4, G, bx);
        EpiRes E{a.in[0], a.in[1], (float*)(ws + WS_X1), (float*)(ws + WS_X1) + (size_t)NP * D, (bf16*)(ws + WS_XB), (float*)(ws + WS_PART)};
        pg8::gemm_phase<EpiRes, OrderRect, true, true>(lds, g, S, E);
    }
    SEAM(5);
    if (IN(6)) {
        __syncthreads();
        { SEpiScale<0> SE{(const float*)(ws + WS_SPART), (bf16*)(ws + WS_QX) + (size_t)NP * D, D};
          sgemm_phase(lds, (const bf16*)(ws + WS_XB) + (size_t)NP * D, (const bf16*)(ws + WS_WXQ), D, 8 * 32, SE, G); }
        pg8::Gemm g{(const bf16*)(ws + WS_XB), (const bf16*)(ws + WS_WXQ), 0, 0, D}; OrderRect S; S.init(64, 4, G, bx);
        EpiScale<0> E{(const float*)(ws + WS_PART), (bf16*)(ws + WS_QX), D};
        pg8::gemm_phase<EpiScale<0>, OrderRect, true, true>(lds, g, S, E);
    }
    SEAM(6);
    if (IN(7)) {
        for (int u = bx; u < 256 + 512; u += G) { if (u < 256) attn_prompt_unit(lds, a, u); else attn_sample_unit(lds, a, u - 256); }
    }
    SEAM(7);
    if (IN(8)) {
        __syncthreads();
        float* x1 = (float*)(ws + WS_X1);
        { SEpiRes SE{x1 + (size_t)NP * D, x1 + (size_t)NP * D, (bf16*)(ws + WS_XB) + (size_t)NP * D, (float*)(ws + WS_SPART + SPART_BYTES)};
          sgemm_phase(lds, (const bf16*)(ws + WS_AO) + (size_t)NP * D, (const bf16*)(ws + WS_WXO), D, 8 * 32, SE, G); }
        pg8::Gemm g{(const bf16*)(ws + WS_AO), (const bf16*)(ws + WS_WXO), 0, 0, D}; OrderRect S; S.init(64, 4, G, bx);
        EpiRes E{x1, x1 + (size_t)NP * D, x1, x1 + (size_t)NP * D, (bf16*)(ws + WS_XB), (float*)(ws + WS_PART + PART_BYTES)};
        pg8::gemm_phase<EpiRes, OrderRect, true, true>(lds, g, S, E);
    }
    SEAM(8);
    if (IN(9)) {
        __syncthreads();
        { SEpiScale<1> SE{(const float*)(ws + WS_SPART + SPART_BYTES), (bf16*)(ws + WS_HB) + (size_t)NP * FF, FF};
          sgemm_phase(lds, (const bf16*)(ws + WS_XB) + (size_t)NP * D, (const bf16*)(ws + WS_WUP), D, 8 * 128, SE, G); }
        pg8::Gemm g{(const bf16*)(ws + WS_XB), (const bf16*)(ws + WS_WUP), 0, 0, D}; OrderRect S; S.init(64, 16, G, bx);
        EpiScale<1> E{(const float*)(ws + WS_PART + PART_BYTES), (bf16*)(ws + WS_HB), FF};
        pg8::gemm_phase<EpiScale<1>, OrderRect, true, true>(lds, g, S, E);
    }
    SEAM(9);
    if (IN(10)) {
        __syncthreads();
        float* x1 = (float*)(ws + WS_X1);
        { SEpiRes SE{x1 + (size_t)NP * D, a.out + O_YS, nullptr, (float*)(ws + WS_SPART + 2 * SPART_BYTES)};
          sgemm_phase(lds, (const bf16*)(ws + WS_HB) + (size_t)NP * FF, (const bf16*)(ws + WS_WDN), FF, 8 * 32, SE, G); }
        pg8::Gemm g{(const bf16*)(ws + WS_HB), (const bf16*)(ws + WS_WDN), 0, 0, FF}; OrderRect S; S.init(64, 4, G, bx);
        EpiRes E{x1, x1 + (size_t)NP * D, a.out + O_YP, a.out + O_YS, nullptr, (float*)(ws + WS_PART + 2 * PART_BYTES)};
        pg8::gemm_phase<EpiRes, OrderRect, true, true>(lds, g, S, E);
    }
    SEAM(10);
    if (IN(11)) phase_final(a, G);
#undef IN
#undef SEAM
}

#ifndef N_LAUNCHES
#define N_LAUNCHES 1
#endif
extern "C" void kernel_launch(void* const* d_in, const int* in_sizes, int n_in, void* d_out, int out_size, void* d_ws, size_t ws_size, hipStream_t stream) {
    static int grid = 0;
    if (grid == 0) {
        if (n_in != 27 || ws_size < WS_END) { fprintf(stderr, "kernel_launch: unexpected n_in %d / ws %zu\n", n_in, ws_size); grid = -1; return; }
        int dev = 0, cus = 0, per_cu = 0;
        (void)hipGetDevice(&dev); (void)hipDeviceGetAttribute(&cus, hipDeviceAttributeMultiprocessorCount, dev);
        if (hipFuncSetAttribute((const void*)hybrid_fwd, hipFuncAttributeMaxDynamicSharedMemorySize, LDS_BYTES) != hipSuccess) { fprintf(stderr, "kernel_launch: hipFuncSetAttribute failed\n"); grid = -1; return; }
        if (hipOccupancyMaxActiveBlocksPerMultiprocessor(&per_cu, (const void*)hybrid_fwd, 512, LDS_BYTES) != hipSuccess || per_cu < 1) { fprintf(stderr, "kernel_launch: occupancy query says %d\n", per_cu); per_cu = 1; }
        (void)hipGetLastError();
        grid = cus * 1;
        fprintf(stderr, "kernel_launch: grid %d (cus %d, per_cu %d)\n", grid, cus, per_cu);
    }
    if (grid < 0) return;
    if (hipMemsetAsync(d_ws, 0, 16384, stream) != hipSuccess) { fprintf(stderr, "kernel_launch: memset failed\n"); return; }
    Args a{};
    for (int i = 0; i < 27; ++i) a.in[i] = (const float*)d_in[i];
    a.out = (float*)d_out; a.ws = (unsigned char*)d_ws;
    if (N_LAUNCHES == 1) {
        a.ph_lo = 0; a.ph_hi = 12;
        void* args[] = {&a};
        hipError_t e = hipLaunchCooperativeKernel((const void*)hybrid_fwd, dim3(grid), dim3(512), args, LDS_BYTES, stream);
        if (e != hipSuccess) fprintf(stderr, "cooperative launch failed: %s (grid %d)\n", hipGetErrorString(e), grid);
    } else {
        for (int p = 0; p < 12; ++p) { a.ph_lo = p; a.ph_hi = p + 1; hipLaunchKernelGGL(hybrid_fwd, dim3(grid), dim3(512), LDS_BYTES, stream, a); }
    }
}
```

```cpp
#include <hip/hip_runtime.h>
#include <hip/hip_cooperative_groups.h>
#include <cstdio>
#include <cstdint>
namespace cg = cooperative_groups;
namespace pg8 {
#define PG8_LAS __attribute__((address_space(3)))
typedef unsigned short bf16_t;
typedef short bf16x8 __attribute__((ext_vector_type(8)));
typedef float f32x4 __attribute__((ext_vector_type(4)));
typedef unsigned u32x4 __attribute__((ext_vector_type(4)));
constexpr int BM = 256, BK = 64, HALF = 128, HTB = HALF * BK * 2  , STAGE_BYTES = 8 * HTB, NXCD = 8, WGM = 8;

__host__ __device__ __forceinline__ int lds_byte(int r, int c) { const int st = (r >> 4) * 2 + (c >> 5), rr = r & 15, cc = c & 31, ob = rr * 64 + cc * 2; return st * 1024 + (ob ^ (((ob >> 9) & 1) << 5)); }
__host__ __device__ __forceinline__ void stage_rc(int b, int& R, int& C) { const int st = b / 1024, sb = b % 1024, swz = sb ^ (((sb >> 9) & 1) << 5); R = (st >> 1) * 16 + swz / 64; C = (st & 1) * 32 + (swz % 64) / 2; }
__host__ __device__ __forceinline__ int perm32(int rho) { const int n = rho >> 4, i = rho & 15; return 8 * (i >> 2) + 4 * n + (i & 3); }

struct Unit { int pm, pn; };
struct Gemm { const bf16_t* A; const bf16_t* Bt; int M, N, K; };
__device__ __forceinline__ unsigned cvt_pk_bf16(float lo, float hi) { unsigned r; asm volatile("v_cvt_pk_bf16_f32 %0, %1, %2" : "=v"(r) : "v"(lo), "v"(hi)); return r; }
template <class Epi, class Sched, bool ALIGN_EPI = false, bool SP2 = false>
__device__ __forceinline__ void gemm_phase(PG8_LAS unsigned char* lds, const Gemm g, const Sched& S, const Epi& E) {
    const int tid = threadIdx.x, wid = __builtin_amdgcn_readfirstlane(tid >> 6), lane = tid & 63, wr = wid >> 2, wc = wid & 3, fr = lane & 15, fq = lane >> 4;
    const int K = g.K, nt = K / BK;
    unsigned voffA[2], voffB[2];
#pragma unroll
    for (int i = 0; i < 2; ++i) { int R, C; stage_rc(tid * 16 + i * 8192, R, C); const int Rb = Epi::PERM ? ((R & ~31) + perm32(R & 31)) : R;
        voffA[i] = (unsigned)(R * K + C) * 2u; voffB[i] = (unsigned)(Rb * K + C) * 2u; }
    const size_t kstep = (size_t)(BK * 2);
    const size_t hstep = (size_t)HALF * K * 2;
    const size_t tstep = 2 * hstep;
    const unsigned ldsw = (unsigned)wid * 1024u;
    const int aoff = lds_byte(wr * 64 + fr, fq * 8), boff = lds_byte(wc * 32 + fr, fq * 8);
#define PG8_SA(b, h) (((b) * 2 + (h)) * HTB)
#define PG8_SB(b, h) ((4 + (b) * 2 + (h)) * HTB)
#define PG8_STAGE(bufoff, gbase, voff) do { _Pragma("unroll") for (int _i = 0; _i < 2; ++_i) \
        __builtin_amdgcn_global_load_lds((const unsigned*)((const char*)(gbase) + (voff)[_i]), (PG8_LAS unsigned*)(lds + (bufoff) + ldsw + _i * 8192), 16, 0, 0); } while (0)
#define PG8_LDA(dst, b, h) do { _Pragma("unroll") for (int m = 0; m < 4; ++m) _Pragma("unroll") for (int k = 0; k < 2; ++k) dst[m][k] = *(const PG8_LAS bf16x8*)(lds + PG8_SA(b, h) + aoff + m * 2048 + k * 1024); } while (0)
#define PG8_LDB(dst, b, h) do { _Pragma("unroll") for (int n = 0; n < 2; ++n) _Pragma("unroll") for (int k = 0; k < 2; ++k) dst[n][k] = *(const PG8_LAS bf16x8*)(lds + PG8_SB(b, h) + boff + n * 2048 + k * 1024); } while (0)
#define PG8_MMA(ai, bj, At, Bt) do { __builtin_amdgcn_s_setprio(1); _Pragma("unroll") for (int m = 0; m < 4; ++m) _Pragma("unroll") for (int n = 0; n < 2; ++n) _Pragma("unroll") for (int k = 0; k < 2; ++k) \
        acc[ai][bj][m][n] = __builtin_amdgcn_mfma_f32_16x16x32_bf16(Bt[n][k], At[m][k], acc[ai][bj][m][n], 0, 0, 0); __builtin_amdgcn_s_setprio(0); } while (0)
#define PG8_WAIT_V(n) asm volatile("s_waitcnt vmcnt(" #n ")" ::: "memory")
#define PG8_WAIT_L(n) asm volatile("s_waitcnt lgkmcnt(" #n ")" ::: "memory")
#define PG8_BAR __builtin_amdgcn_s_barrier()
#define PG8_SCHED __builtin_amdgcn_sched_barrier(0)
    Unit cur, nxt; int ui = 0;
    if (!S.next(0, cur)) return;
    f32x4 acc[2][2][4][2];
#pragma unroll
    for (int a = 0; a < 2; ++a)
#pragma unroll
        for (int b = 0; b < 2; ++b)
#pragma unroll
            for (int m = 0; m < 4; ++m)
#pragma unroll
                for (int n = 0; n < 2; ++n) acc[a][b][m][n] = (f32x4){0.f, 0.f, 0.f, 0.f};
    bf16x8 At[4][2], B0[2][2], B1[2][2];
    const char* cA = (const char*)g.A + (size_t)cur.pm * tstep; const char* cB = (const char*)g.Bt + (size_t)cur.pn * tstep;
    S.a_ready(cur);
    if constexpr (SP2) {
        PG8_STAGE(PG8_SB(0, 0), cB, voffB); PG8_STAGE(PG8_SB(0, 1), cB + hstep, voffB); PG8_STAGE(PG8_SA(0, 0), cA, voffA); PG8_STAGE(PG8_SA(0, 1), cA + hstep, voffA);
        if (wr == 1) PG8_BAR;
        PG8_WAIT_V(2); PG8_BAR;
        PG8_STAGE(PG8_SB(1, 0), cB + kstep, voffB); PG8_STAGE(PG8_SA(1, 0), cA + kstep, voffA); PG8_STAGE(PG8_SB(1, 1), cB + hstep + kstep, voffB);
        PG8_WAIT_V(6); PG8_BAR;
    } else {
        PG8_STAGE(PG8_SB(0, 0), cB, voffB); PG8_STAGE(PG8_SA(0, 0), cA, voffA); PG8_STAGE(PG8_SB(0, 1), cB + hstep, voffB); PG8_STAGE(PG8_SA(0, 1), cA + hstep, voffA);
        if (wr == 1) PG8_BAR;
        PG8_WAIT_V(4); PG8_BAR;
        PG8_STAGE(PG8_SB(1, 0), cB + kstep, voffB); PG8_STAGE(PG8_SA(1, 0), cA + kstep, voffA); PG8_STAGE(PG8_SB(1, 1), cB + hstep + kstep, voffB);
        PG8_WAIT_V(6); PG8_BAR;
    }
    for (;;) {
        const bool has_next = S.next(ui + 1, nxt);
        const char* nA = has_next ? (const char*)g.A + (size_t)nxt.pm * tstep : cA; const char* nB = has_next ? (const char*)g.Bt + (size_t)nxt.pn * tstep : cB;
        for (int t = 0; t < nt; t += 2) {
            const bool last = (t == nt - 2);
            const char* a1 = cA + (size_t)(t + 1) * kstep;
            const char* a2 = last ? nA : cA + (size_t)(t + 2) * kstep; const char* b2 = last ? nB : cB + (size_t)(t + 2) * kstep;
            const char* a3 = a2 + kstep; const char* b3 = b2 + kstep;
            if (last && has_next) S.a_ready(nxt);
            if constexpr (SP2) {
            PG8_LDB(B0, 0, 0); PG8_LDB(B1, 0, 1); PG8_SCHED; PG8_LDA(At, 0, 0); PG8_STAGE(PG8_SA(1, 1), a1 + hstep, voffA);
            PG8_WAIT_V(8); PG8_WAIT_L(0); PG8_BAR; PG8_MMA(0, 0, At, B0); PG8_MMA(0, 1, At, B1); PG8_BAR; PG8_SCHED;
            PG8_LDA(At, 0, 1); PG8_STAGE(PG8_SB(0, 0), b2, voffB); PG8_STAGE(PG8_SB(0, 1), b2 + hstep, voffB); PG8_STAGE(PG8_SA(0, 0), a2, voffA);
            PG8_WAIT_V(8); PG8_WAIT_L(0); PG8_BAR; PG8_MMA(1, 0, At, B0); PG8_MMA(1, 1, At, B1); PG8_BAR; PG8_SCHED;
            PG8_LDB(B0, 1, 0); PG8_LDB(B1, 1, 1); PG8_SCHED; PG8_LDA(At, 1, 0); PG8_STAGE(PG8_SA(0, 1), a2 + hstep, voffA);
            PG8_WAIT_V(8); PG8_WAIT_L(0); PG8_BAR; PG8_MMA(0, 0, At, B0); PG8_MMA(0, 1, At, B1); PG8_BAR; PG8_SCHED;
            PG8_LDA(At, 1, 1); PG8_STAGE(PG8_SB(1, 0), b3, voffB); PG8_STAGE(PG8_SB(1, 1), b3 + hstep, voffB); PG8_STAGE(PG8_SA(1, 0), a3, voffA);
            PG8_WAIT_V(8); PG8_WAIT_L(0); PG8_BAR; PG8_MMA(1, 0, At, B0); PG8_MMA(1, 1, At, B1); PG8_BAR; PG8_SCHED;
            } else {
            PG8_LDB(B0, 0, 0); PG8_SCHED; PG8_LDA(At, 0, 0); PG8_STAGE(PG8_SA(1, 1), a1 + hstep, voffA);
            PG8_WAIT_L(8); PG8_BAR; PG8_WAIT_L(0); PG8_MMA(0, 0, At, B0); PG8_BAR; PG8_SCHED;
            PG8_LDB(B1, 0, 1); PG8_STAGE(PG8_SB(0, 0), b2, voffB);
            PG8_BAR; PG8_WAIT_L(0); PG8_MMA(0, 1, At, B1); PG8_BAR;
            PG8_LDA(At, 0, 1); PG8_STAGE(PG8_SA(0, 0), a2, voffA);
            PG8_BAR; PG8_WAIT_L(0); PG8_MMA(1, 0, At, B0); PG8_BAR; PG8_SCHED;
            PG8_STAGE(PG8_SB(0, 1), b2 + hstep, voffB);
            PG8_WAIT_V(6); PG8_BAR; PG8_MMA(1, 1, At, B1); PG8_BAR;
            PG8_LDB(B0, 1, 0); PG8_SCHED; PG8_LDA(At, 1, 0); PG8_STAGE(PG8_SA(0, 1), a2 + hstep, voffA);
            PG8_WAIT_L(8); PG8_BAR; PG8_WAIT_L(0); PG8_MMA(0, 0, At, B0); PG8_BAR; PG8_SCHED;
            PG8_LDB(B1, 1, 1); PG8_STAGE(PG8_SB(1, 0), b3, voffB);
            PG8_BAR; PG8_WAIT_L(0); PG8_MMA(0, 1, At, B1); PG8_BAR;
            PG8_LDA(At, 1, 1); PG8_STAGE(PG8_SA(1, 0), a3, voffA);
            PG8_BAR; PG8_WAIT_L(0); PG8_MMA(1, 0, At, B0); PG8_BAR; PG8_SCHED;
            PG8_STAGE(PG8_SB(1, 1), b3 + hstep, voffB);
            PG8_WAIT_V(6); PG8_BAR; PG8_MMA(1, 1, At, B1); PG8_BAR;
            }
        }
        if constexpr (ALIGN_EPI) { if (wr == 0) PG8_BAR; }
        if constexpr (!Epi::AFTER_DRAIN) { E(acc, cur, wr, wc, fr, fq); S.done(cur); }
        if (!has_next) break;
#pragma unroll
        for (int a = 0; a < 2; ++a)
#pragma unroll
            for (int b = 0; b < 2; ++b)
#pragma unroll
                for (int m = 0; m < 4; ++m)
#pragma unroll
                    for (int n = 0; n < 2; ++n) acc[a][b][m][n] = (f32x4){0.f, 0.f, 0.f, 0.f};
        cur = nxt; cA = nA; cB = nB; ++ui;
        if constexpr (ALIGN_EPI) { if (wr == 1) PG8_BAR; }
    }
    PG8_WAIT_V(0);
    if constexpr (!ALIGN_EPI) { if (wr == 0) PG8_BAR; }
    PG8_BAR;
    if constexpr (Epi::AFTER_DRAIN) { E.fused(acc, cur, wr, wc, fr, fq, lds, wid, lane); S.done(cur); }
#undef PG8_SA
#undef PG8_SB
#undef PG8_STAGE
#undef PG8_LDA
#undef PG8_LDB
#undef PG8_MMA
#undef PG8_WAIT_V
#undef PG8_WAIT_L
#undef PG8_BAR
#undef PG8_SCHED
}
}

#define LAS __attribute__((address_space(3)))
typedef unsigned short bf16;
typedef pg8::bf16x8 bf16x8;
typedef pg8::f32x4 f32x4;
typedef pg8::u32x4 u32x4;
typedef float f32x16 __attribute__((ext_vector_type(16)));
typedef unsigned u32x2 __attribute__((ext_vector_type(2)));
using pg8::cvt_pk_bf16;

constexpr int NP = 16384, NS = 128, NROW = NP + NS, MALL = 16640, D = 1024, FF = 4096, TSEQ = 2048;
constexpr int NIN = 2816;
constexpr int PJ = 2048;
constexpr int PJ_Q = 512, PJ_K = 768, PJ_V = 1024, PJ_R = 1536;
constexpr float EPS = 1e-6f;
constexpr int NCHUNK = 32, CH = 64;

constexpr size_t MiB = 1u << 20;
constexpr size_t WS_PART = 1 * MiB;
constexpr size_t PART_BYTES = (size_t)MALL * 16 * 4;
constexpr size_t WS_SPART = 4 * MiB + 512 * 1024, SPART_BYTES = 128 * 32 * 4;
constexpr size_t WS_DEC = 5 * MiB;
constexpr size_t WS_WCAT = 6 * MiB;
constexpr size_t WS_WOUT = 16 * MiB, WS_WXQ = 18 * MiB, WS_WXO = 20 * MiB, WS_WUP = 22 * MiB, WS_WDN = 30 * MiB;
constexpr size_t WS_MKB = 38 * MiB, WS_MVB = 42 * MiB, WS_MVT = 46 * MiB;
constexpr size_t WS_XN = 50 * MiB;
constexpr size_t WS_LA = 87 * MiB;
constexpr size_t WS_X1 = 104 * MiB;
constexpr size_t WS_XB = 169 * MiB;
constexpr size_t WS_QX = 202 * MiB;
constexpr size_t WS_AO = 235 * MiB;
constexpr size_t WS_SB = 268 * MiB;
constexpr size_t WS_PROJ = 284 * MiB;
constexpr size_t WS_MIX = 349 * MiB;
constexpr size_t WS_KV = 382 * MiB;
constexpr size_t WS_HB = 284 * MiB;
constexpr size_t WS_LB = 414 * MiB;
constexpr size_t WS_END = 431 * MiB;

constexpr size_t O_YP = 0, O_YS = 16777216, O_CP = 16908288, O_CS = 17031168, O_GP = 18997248, O_GS = 19259392, O_MK = 23453696, O_MV = 25550848;

constexpr int LDS_BYTES = 147456;

__device__ __forceinline__ float bf2f(unsigned short b) { return __uint_as_float(((unsigned)b) << 16); }
__device__ __forceinline__ float bflo(unsigned w) { return __uint_as_float(w << 16); }
__device__ __forceinline__ float bfhi(unsigned w) { return __uint_as_float(w & 0xffff0000u); }
__device__ __forceinline__ unsigned short f2bf(float f) { return (unsigned short)(cvt_pk_bf16(f, 0.f) & 0xffffu); }
__device__ __forceinline__ float sigmoidf_(float x) { return 1.0f / (1.0f + __expf(-x)); }
__device__ __forceinline__ float siluf_(float x) { return x / (1.0f + __expf(-x)); }
__device__ __forceinline__ float wave_sum(float v) {
#pragma unroll
    for (int o = 1; o < 64; o <<= 1) v += __shfl_xor(v, o);
    return v;
}
__device__ __forceinline__ float wave_max(float v) {
#pragma unroll
    for (int o = 1; o < 64; o <<= 1) v = fmaxf(v, __shfl_xor(v, o));
    return v;
}
__device__ __forceinline__ u32x4 pack8(f32x4 a, f32x4 b) { u32x4 w; w.x = cvt_pk_bf16(a[0], a[1]); w.y = cvt_pk_bf16(a[2], a[3]); w.z = cvt_pk_bf16(b[0], b[1]); w.w = cvt_pk_bf16(b[2], b[3]); return w; }
#define LDS_WAIT() asm volatile("s_waitcnt lgkmcnt(0)" ::: "memory")

#define RLX_AGENT __ATOMIC_RELAXED, __HIP_MEMORY_SCOPE_AGENT
#define XB_TMO      128
#define XB_XCNT(j)  (256  + 64 * (j))
#define XB_XSUB(j)  (1280 + 64 * (j))
#define XB_XGEN(j)  (2304 + 64 * (j))
#define XB_TOP      3328
#define XB_TOPGEN   3392
#define XCD_BAR_WORDS 3456
#define XB_SPIN_CAP (1u << 18)

__device__ __forceinline__ unsigned xb_ld(unsigned* p)              { return __hip_atomic_load(p, __ATOMIC_RELAXED, __HIP_MEMORY_SCOPE_AGENT); }
__device__ __forceinline__ unsigned xb_add(unsigned* p, unsigned v) { return __hip_atomic_fetch_add(p, v, __ATOMIC_RELAXED, __HIP_MEMORY_SCOPE_AGENT); }
__device__ __forceinline__ unsigned xb_xcc_id() { return (unsigned)__builtin_amdgcn_s_getreg((3 << 11) | 20) & 0xFu; }
#define XB_SPIN(cond, bar) do { unsigned _sp = 0; while (cond) { __builtin_amdgcn_s_sleep(1); \
    if ((++_sp & 255u) == 0u) { if (xb_ld(&(bar)[XB_TMO])) break; if (_sp > XB_SPIN_CAP) { atomicAdd(&(bar)[XB_TMO], 1u); break; } } } } while (0)

struct XcdBarrier {
    unsigned* bar; unsigned x;
    volatile LAS unsigned* st;
};

__device__ __forceinline__ XcdBarrier xcd_barrier_post(unsigned* bar, volatile LAS unsigned* st) {
    XcdBarrier b; b.bar = bar; b.x = xb_xcc_id(); b.st = st;
    if (threadIdx.x == 0) (void)xb_add(&bar[XB_XCNT(b.x)], 1u);
    return b;
}
__device__ __forceinline__ void xcd_barrier_complete(unsigned* bar, unsigned x, unsigned& nloc, unsigned& nx) {
    const unsigned G = gridDim.x * gridDim.y * gridDim.z;
    unsigned sum, cnt, mine, sp = 0u;
    for (;;) {
        sum = 0u; cnt = 0u; mine = 0u;
#pragma unroll
        for (unsigned j = 0; j < 16; ++j) { const unsigned c = xb_ld(&bar[XB_XCNT(j)]); sum += c; cnt += (c > 0u) ? 1u : 0u; mine = (j == x) ? c : mine; }
        if (sum == G) break;
        __builtin_amdgcn_s_sleep(1);
        if ((++sp & 255u) == 0u) { if (xb_ld(&bar[XB_TMO])) break; if (sp > XB_SPIN_CAP) { atomicAdd(&bar[XB_TMO], 1u); break; } }
    }
    nloc = mine > 0u ? mine : 1u; nx = cnt > 0u ? cnt : 1u;
}

__device__ __forceinline__ void xcd_barrier(const XcdBarrier& b) {
    asm volatile("s_waitcnt vmcnt(0)" ::: "memory");
    __syncthreads();
    if (threadIdx.x == 0) {
        unsigned* bar = b.bar;
        __builtin_amdgcn_s_waitcnt(0);
        unsigned nloc = b.st[0], nx = b.st[1];
        if (nloc == 0u) { xcd_barrier_complete(bar, b.x, nloc, nx); b.st[0] = nloc; b.st[1] = nx; }
        const unsigned old = xb_add(&bar[XB_XSUB(b.x)], 1u);
        const unsigned gen = old / nloc;
        if (old + 1u == (gen + 1u) * nloc) {
            __builtin_amdgcn_fence(__ATOMIC_RELEASE, "agent");
            asm volatile("s_waitcnt vmcnt(0)" ::: "memory");
            const unsigned og = xb_add(&bar[XB_TOP], 1u);
            const unsigned tg = og / nx;
            if (og + 1u == (tg + 1u) * nx) xb_add(&bar[XB_TOPGEN], 1u);
            else XB_SPIN(xb_ld(&bar[XB_TOPGEN]) == tg, bar);
            __builtin_amdgcn_fence(__ATOMIC_ACQUIRE, "agent");
            xb_add(&bar[XB_XGEN(b.x)], 1u);
            asm volatile("s_waitcnt vmcnt(0)" ::: "memory");
        } else {
            XB_SPIN(xb_ld(&bar[XB_XGEN(b.x)]) == gen, bar);
            __builtin_amdgcn_fence(__ATOMIC_ACQUIRE, "agent");
            asm volatile("s_waitcnt vmcnt(0)" ::: "memory");
        }
    }
    __syncthreads();
}


struct Args { const float* in[27]; float* out; unsigned char* ws; int ph_lo, ph_hi; };

struct OrderRect {
    int nM, nN, nwg, G, c, n2M, n2N, pm2, pn2;
    __device__ void init(int nM_, int nN_, int G_, int c_, int n2M_ = 0, int n2N_ = 0, int pm2_ = 0, int pn2_ = 0) { nM = nM_; nN = nN_; nwg = nM * nN; G = G_; c = c_; n2M = n2M_; n2N = n2N_; pm2 = pm2_; pn2 = pn2_; }
    __device__ bool next(int i, pg8::Unit& u) const {
        long L = (long)i * G + c;
        if (L < nwg) {
            int wgid = (int)L; { const int q = nwg / 8, r = nwg % 8, xcd = wgid % 8, off = wgid / 8; wgid = (xcd < r ? xcd * (q + 1) : r * (q + 1) + (xcd - r) * q) + off; }
            const int nig = 8 * nN, gid = wgid / nig, fm = gid * 8, gsz = (nM - fm) < 8 ? (nM - fm) : 8;
            u.pm = fm + ((wgid % nig) % gsz); u.pn = (wgid % nig) / gsz; return true;
        }
        L -= nwg;
        if (L < (long)n2M * n2N) { u.pm = pm2 + (int)(L % n2M); u.pn = pn2 + (int)(L / n2M); return true; }
        return false;
    }
    __device__ __forceinline__ void a_ready(const pg8::Unit&) const {}
    __device__ __forceinline__ void done(const pg8::Unit&) const {}
};

struct EpiG1 {
    static constexpr bool PERM = true, AFTER_DRAIN = false;
    bf16* proj; float* la; const float* b_alpha; float* conv_p; float* conv_s; float* mk_out; float* mv_out; bf16* mkb; bf16* mvb;
    __device__ __forceinline__ void operator()(const f32x4 (&acc)[2][2][4][2], const pg8::Unit& u, int wr, int wc, int fr, int fq) const {
        const int pm = u.pm, pn = u.pn;
        if (pm < 65) {
            if (pn < 4) {
                const int ch = 128 * pn + 32 * wc + 8 * fq;
#pragma unroll
                for (int ai = 0; ai < 2; ++ai) {
                    if (256 * pm + 128 * ai >= NROW) continue;
#pragma unroll
                    for (int m = 0; m < 4; ++m) {
                        const int row = 256 * pm + 128 * ai + 64 * wr + 16 * m + fr;
                        f32x4 u0, u1;
#pragma unroll
                        for (int j = 0; j < 4; ++j) { u0[j] = acc[ai][0][m][0][j] * sigmoidf_(acc[ai][1][m][0][j]); u1[j] = acc[ai][0][m][1][j] * sigmoidf_(acc[ai][1][m][1][j]); }
                        *(u32x4*)(proj + (size_t)row * PJ + ch) = pack8(u0, u1);
                        if (row < NP) { const int t = row & (TSEQ - 1); if (t >= TSEQ - 30) { float* p = conv_p + ((size_t)((row >> 11) * 30 + (t - (TSEQ - 30)))) * 512 + ch; *(f32x4*)p = u0; *(f32x4*)(p + 4) = u1; } }
                        else { float* p = conv_s + ((size_t)((row - NP) * 30 + 29)) * 512 + ch; *(f32x4*)p = u0; *(f32x4*)(p + 4) = u1; }
                    }
                }
            } else if (pn < 10) {
                const bool act = pn >= 8;
#pragma unroll
                for (int ai = 0; ai < 2; ++ai) {
                    if (256 * pm + 128 * ai >= NROW) continue;
#pragma unroll
                    for (int m = 0; m < 4; ++m) {
                        const int row = 256 * pm + 128 * ai + 64 * wr + 16 * m + fr;
#pragma unroll
                        for (int bj = 0; bj < 2; ++bj) {
                            const int col = 512 + 256 * (pn - 4) + 128 * bj + 32 * wc + 8 * fq;
                            f32x4 v0 = acc[ai][bj][m][0], v1 = acc[ai][bj][m][1];
                            if (act) {
#pragma unroll
                                for (int j = 0; j < 4; ++j) { v0[j] = siluf_(v0[j]); v1[j] = siluf_(v1[j]); }
                            }
                            *(u32x4*)(proj + (size_t)row * PJ + col) = pack8(v0, v1);
                        }
                    }
                }
            } else {
#pragma unroll
                for (int bj = 0; bj < 2; ++bj) {
                    const int c = 128 * bj + 32 * wc + 8 * fq;
                    const f32x4 b0 = *(const f32x4*)(b_alpha + c), b1 = *(const f32x4*)(b_alpha + c + 4);
#pragma unroll
                    for (int ai = 0; ai < 2; ++ai) {
                        if (256 * pm + 128 * ai >= NROW) continue;
#pragma unroll
                        for (int m = 0; m < 4; ++m) {
                            const int row = 256 * pm + 128 * ai + 64 * wr + 16 * m + fr;
                            f32x4 z0 = acc[ai][bj][m][0] + b0, z1 = acc[ai][bj][m][1] + b1;
#pragma unroll
                            for (int j = 0; j < 4; ++j) {
                                z0[j] = (fminf(z0[j], 0.f) - __logf(1.0f + __expf(-fabsf(z0[j])))) * 0.0625f;
                                z1[j] = (fminf(z1[j], 0.f) - __logf(1.0f + __expf(-fabsf(z1[j])))) * 0.0625f;
                            }
                            float* p = la + (size_t)row * 256 + c; *(f32x4*)p = z0; *(f32x4*)(p + 4) = z1;
                        }
                    }
                }
            }
        } else {
            const int cb = 256 * (pn - 11);
            const bool isk = cb < 1024;
            float* of = isk ? mk_out : mv_out; bf16* ob = isk ? mkb : mvb; const int c0 = isk ? cb : cb - 1024;
#pragma unroll
            for (int ai = 0; ai < 2; ++ai)
#pragma unroll
                for (int m = 0; m < 4; ++m) {
                    const int row = 256 * (pm - 65) + 128 * ai + 64 * wr + 16 * m + fr;
#pragma unroll
                    for (int bj = 0; bj < 2; ++bj) {
                        const int col = c0 + 128 * bj + 32 * wc + 8 * fq;
                        const f32x4 v0 = acc[ai][bj][m][0], v1 = acc[ai][bj][m][1];
                        float* p = of + (size_t)row * 1024 + col; *(f32x4*)p = v0; *(f32x4*)(p + 4) = v1;
                        *(u32x4*)(ob + (size_t)row * 1024 + col) = pack8(v0, v1);
                    }
                }
        }
    }
};

struct EpiRes {
    static constexpr bool PERM = true, AFTER_DRAIN = false;
    const float* rp; const float* rs; float* op; float* os; bf16* ob; float* part;
    __device__ __forceinline__ void operator()(const f32x4 (&acc)[2][2][4][2], const pg8::Unit& u, int wr, int wc, int fr, int fq) const {
        const int pm = u.pm, pn = u.pn;
#pragma unroll
        for (int ai = 0; ai < 2; ++ai) {
            if (256 * pm + 128 * ai >= NROW) continue;
#pragma unroll
            for (int m = 0; m < 4; ++m) {
                const int row = 256 * pm + 128 * ai + 64 * wr + 16 * m + fr;
                const float* rr = row < NP ? rp + (size_t)row * D : rs + (size_t)(row - NP) * D;
                float* oo = row < NP ? op + (size_t)row * D : os + (size_t)(row - NP) * D;
                float ss = 0.f;
#pragma unroll
                for (int bj = 0; bj < 2; ++bj) {
                    const int col = 256 * pn + 128 * bj + 32 * wc + 8 * fq;
                    const f32x4 x0 = *(const f32x4*)(rr + col) + acc[ai][bj][m][0], x1 = *(const f32x4*)(rr + col + 4) + acc[ai][bj][m][1];
                    *(f32x4*)(oo + col) = x0; *(f32x4*)(oo + col + 4) = x1;
                    if (ob) *(u32x4*)(ob + (size_t)row * D + col) = pack8(x0, x1);
                    ss += (x0[0] * x0[0] + x0[1] * x0[1]) + (x0[2] * x0[2] + x0[3] * x0[3]) + (x1[0] * x1[0] + x1[1] * x1[1]) + (x1[2] * x1[2] + x1[3] * x1[3]);
                }
                ss += __shfl_xor(ss, 16); ss += __shfl_xor(ss, 32);
                if (fq == 0) part[(size_t)row * 16 + pn * 4 + wc] = ss;
            }
        }
    }
};

template <int MODE  > struct EpiScale {
    static constexpr bool PERM = true, AFTER_DRAIN = false;
    const float* part; bf16* o; int ldc;
    __device__ __forceinline__ void operator()(const f32x4 (&acc)[2][2][4][2], const pg8::Unit& u, int wr, int wc, int fr, int fq) const {
        const int pm = u.pm, pn = u.pn;
#pragma unroll
        for (int ai = 0; ai < 2; ++ai) {
            if (256 * pm + 128 * ai >= NROW) continue;
#pragma unroll
            for (int m = 0; m < 4; ++m) {
                const int row = 256 * pm + 128 * ai + 64 * wr + 16 * m + fr;
                const f32x4* pp = (const f32x4*)(part + (size_t)row * 16);
                const f32x4 p0 = pp[0], p1 = pp[1], p2 = pp[2], p3 = pp[3];
                const f32x4 ps = (p0 + p1) + (p2 + p3);
                const float rstd = rsqrtf(((ps[0] + ps[1]) + (ps[2] + ps[3])) * (1.0f / D) + EPS);
#pragma unroll
                for (int bj = 0; bj < 2; ++bj) {
                    const int col = 256 * pn + 128 * bj + 32 * wc + 8 * fq;
                    f32x4 v0 = acc[ai][bj][m][0] * rstd, v1 = acc[ai][bj][m][1] * rstd;
                    if (MODE == 1) {
#pragma unroll
                        for (int j = 0; j < 4; ++j) { const float a = fmaxf(v0[j], 0.f), b = fmaxf(v1[j], 0.f); v0[j] = a * a; v1[j] = b * b; }
                    }
                    *(u32x4*)(o + (size_t)row * ldc + col) = pack8(v0, v1);
                }
            }
        }
    }
};


typedef float f32x4s __attribute__((ext_vector_type(4)));
template <class EpiS>
__device__ __forceinline__ void sgemm_phase(LAS unsigned char* lds, const bf16* A, const bf16* Bt, int K, int nitems, const EpiS& E, int G) {
    int tid_ = threadIdx.x; asm volatile("" : "+v"(tid_)); const int tid = tid_;
    const int lane = tid & 63, w = tid >> 6, fr = lane & 15, fq = lane >> 4, tile = w & 1, kq = w >> 1;
    LAS float* red = (LAS float*)(lds + 131072);
    const int kper = K >> 2;
    for (int item = blockIdx.x; item < nitems; item += G) {
        const int rb = item & 7, cg = item >> 3;
        int c0, c1; E.cols(cg, c0, c1);
        const int cc = tile ? c1 : c0;
        const bf16* ap = A + (size_t)(16 * rb + fr) * K + kq * kper + 8 * fq;
        const bf16* bp = Bt + (size_t)(cc + fr) * K + kq * kper + 8 * fq;
        f32x4 acc = {0.f, 0.f, 0.f, 0.f};
#pragma unroll 8
        for (int s = 0; s < kper / 32; ++s) { const bf16x8 av = *(const bf16x8*)(ap + 32 * s), bv = *(const bf16x8*)(bp + 32 * s); acc = __builtin_amdgcn_mfma_f32_16x16x32_bf16(av, bv, acc, 0, 0, 0); }
        __syncthreads();
#pragma unroll
        for (int i = 0; i < 4; ++i) red[w * 256 + (4 * fq + i) * 16 + fr] = acc[i];
        __syncthreads();
        if (tid < 256) {
            const float v0 = (red[0 * 256 + tid] + red[2 * 256 + tid]) + (red[4 * 256 + tid] + red[6 * 256 + tid]);
            const float v1 = (red[1 * 256 + tid] + red[3 * 256 + tid]) + (red[5 * 256 + tid] + red[7 * 256 + tid]);
            E.apply(16 * rb + (tid >> 4), tid & 15, c0, c1, v0, v1, cg);
        }
    }
}
struct SEpiG1 {
    bf16* proj; float* la; const float* b_alpha; float* conv_s;
    __device__ __forceinline__ void cols(int cg, int& c0, int& c1) const { if (cg < 32) { c0 = 256 * (cg >> 3) + 16 * (cg & 7); c1 = c0 + 128; } else { c0 = 1024 + 32 * (cg - 32); c1 = c0 + 16; } }
    __device__ __forceinline__ void one(int r, int j, float v) const {
        const size_t row = (size_t)(NP + r);
        if (j < 2560) { proj[row * PJ + j - 512] = f2bf(j >= 2048 ? siluf_(v) : v); }
        else { const int cp = j - 2560; const float z = v + b_alpha[cp]; la[row * 256 + cp] = (fminf(z, 0.f) - __logf(1.0f + __expf(-fabsf(z)))) * 0.0625f; }
    }
    __device__ __forceinline__ void apply(int r, int c, int c0, int c1, float v0, float v1, int cg) const {
        if (cg < 32) { const int ch = 128 * (c0 >> 8) + (c0 & 127) + c; const float u = v0 * sigmoidf_(v1); proj[(size_t)(NP + r) * PJ + ch] = f2bf(u); conv_s[(size_t)(r * 30 + 29) * 512 + ch] = u; }
        else { one(r, c0 + c, v0); one(r, c1 + c, v1); }
    }
};
struct SEpiRes {
    const float* rs; float* os; bf16* ob; float* part;
    __device__ __forceinline__ void cols(int cg, int& c0, int& c1) const { c0 = 32 * cg; c1 = c0 + 16; }
    __device__ __forceinline__ void apply(int r, int c, int c0, int c1, float v0, float v1, int cg) const {
        const size_t o0 = (size_t)r * D + c0 + c, o1 = (size_t)r * D + c1 + c;
        const float x0 = rs[o0] + v0, x1 = rs[o1] + v1;
        os[o0] = x0; os[o1] = x1;
        if (ob) { ob[o0] = f2bf(x0); ob[o1] = f2bf(x1); }
        float ss = x0 * x0 + x1 * x1;
        ss += __shfl_xor(ss, 1); ss += __shfl_xor(ss, 2); ss += __shfl_xor(ss, 4); ss += __shfl_xor(ss, 8);
        if (c == 0) part[r * 32 + cg] = ss;
    }
};
template <int MODE> struct SEpiScale {
    const float* part; bf16* o; int ldc;
    __device__ __forceinline__ void cols(int cg, int& c0, int& c1) const { c0 = 32 * cg; c1 = c0 + 16; }
    __device__ __forceinline__ void apply(int r, int c, int c0, int c1, float v0, float v1, int cg) const {
        const f32x4* pp = (const f32x4*)(part + r * 32); f32x4 ps = pp[0];
#pragma unroll
        for (int i = 1; i < 8; ++i) ps = ps + pp[i];
        const float rstd = rsqrtf(((ps[0] + ps[1]) + (ps[2] + ps[3])) * (1.0f / D) + EPS);
        v0 *= rstd; v1 *= rstd;
        if (MODE == 1) { v0 = fmaxf(v0, 0.f); v0 *= v0; v1 = fmaxf(v1, 0.f); v1 *= v1; }
        o[(size_t)r * ldc + c0 + c] = f2bf(v0); o[(size_t)r * ldc + c1 + c] = f2bf(v1);
    }
};

struct TItem { const float* W; bf16* WT; const float* gk; int N, K, k0, n0, drow; float sc; };
__device__ __forceinline__ TItem titem_decode(const Args& a, int it) {
    constexpr int I_IN = 16 * 80, I_SQ = 16 * 32, I_UP = 16 * 128;
    unsigned char* ws = a.ws; TItem t; t.gk = nullptr; t.sc = 1.f; t.N = D; t.K = D;
    int r = it;
    if (r < I_IN) { const int kb = r / 80, nb = r % 80, n0 = nb * 32; int drow;
        if (n0 < 512) drow = 256 * (n0 >> 7) + (n0 & 127);
        else if (n0 < 1024) { const int c = n0 - 512; drow = 256 * (c >> 7) + 128 + (c & 127); }
        else { drow = n0; if (n0 < 1280) t.sc = 0.125f; }
        t.W = a.in[8]; t.WT = (bf16*)(ws + WS_WCAT); t.N = 2576; t.k0 = kb * 64; t.n0 = n0; t.drow = drow; return t; }
    r -= I_IN;
    if (r < 5 * I_SQ) { const int q = r / I_SQ; r -= q * I_SQ; t.k0 = (r / 32) * 64; t.n0 = (r % 32) * 32; t.drow = t.n0;
        if (q == 0) { t.W = a.in[20]; t.WT = (bf16*)(ws + WS_WCAT); t.drow += NIN; }
        else if (q == 1) { t.W = a.in[21]; t.WT = (bf16*)(ws + WS_WCAT); t.drow += NIN + 1024; }
        else if (q == 2) { t.W = a.in[16]; t.WT = (bf16*)(ws + WS_WOUT); }
        else if (q == 3) { t.W = a.in[19]; t.WT = (bf16*)(ws + WS_WXQ); t.gk = a.in[17]; t.sc = 0.0625f; }
        else { t.W = a.in[22]; t.WT = (bf16*)(ws + WS_WXO); }
        return t; }
    r -= 5 * I_SQ;
    if (r < I_UP) { t.W = a.in[24]; t.WT = (bf16*)(ws + WS_WUP); t.gk = a.in[23]; t.N = FF; t.k0 = (r / 128) * 64; t.n0 = (r % 128) * 32; t.drow = t.n0; return t; }
    r -= I_UP;
    t.W = a.in[25]; t.WT = (bf16*)(ws + WS_WDN); t.K = FF; t.k0 = (r / 32) * 64; t.n0 = (r % 32) * 32; t.drow = t.n0; return t;
}
__device__ __forceinline__ void titem_load(const TItem& t, f32x4 (&v)[8], int lane) {
#pragma unroll
    for (int i = 0; i < 8; ++i) v[i] = *(const f32x4*)(t.W + (size_t)(t.k0 + (lane >> 3) + 8 * i) * t.N + t.n0 + 4 * (lane & 7));
}
__device__ __forceinline__ void titem_store(const TItem& t, const f32x4 (&v)[8], LAS float* scr, int lane) {
#pragma unroll
    for (int i = 0; i < 8; ++i) { const int kk = (lane >> 3) + 8 * i; const float g = t.gk ? t.gk[t.k0 + kk] * t.sc : t.sc; LAS float* p = scr + kk * 33 + 4 * (lane & 7);
        p[0] = v[i][0] * g; p[1] = v[i][1] * g; p[2] = v[i][2] * g; p[3] = v[i][3] * g; }
    LDS_WAIT(); asm volatile("" ::: "memory");
    const int c = lane & 7;
#pragma unroll
    for (int j = 0; j < 4; ++j) { const int n = (lane >> 3) + 8 * j; const LAS float* q = scr + (8 * c) * 33 + n;
        u32x4 o; o.x = cvt_pk_bf16(q[0 * 33], q[1 * 33]); o.y = cvt_pk_bf16(q[2 * 33], q[3 * 33]); o.z = cvt_pk_bf16(q[4 * 33], q[5 * 33]); o.w = cvt_pk_bf16(q[6 * 33], q[7 * 33]);
        *(u32x4*)(t.WT + (size_t)(t.drow + n) * t.K + t.k0 + 8 * c) = o; }
    LDS_WAIT(); asm volatile("" ::: "memory");
}
__device__ __forceinline__ const float* xn_src(const Args& a, int m, const float*& g, size_t& orow) {
    if (m < NP) { g = a.in[7]; orow = m; return a.in[0] + (size_t)m * D; }
    if (m < NROW) { g = a.in[7]; orow = m; return a.in[1] + (size_t)(m - NP) * D; }
    g = a.in[18]; orow = (size_t)MALL + (m - NROW); return a.in[6] + (size_t)(m - NROW) * D;
}
__device__ __forceinline__ void norm_rows2(const Args& a, int m0, int m1, bool has1, bf16* xn, int lane) {
    const float *g0, *g1; size_t o0, o1;
    const float* x0 = xn_src(a, m0, g0, o0); const float* x1 = xn_src(a, has1 ? m1 : m0, g1, o1);
    f32x4 v0[4], v1[4]; float s0 = 0.f, s1 = 0.f;
#pragma unroll
    for (int j = 0; j < 4; ++j) { v0[j] = ((const f32x4*)x0)[lane + 64 * j]; v1[j] = ((const f32x4*)x1)[lane + 64 * j]; }
#pragma unroll
    for (int j = 0; j < 4; ++j) { s0 += (v0[j][0] * v0[j][0] + v0[j][1] * v0[j][1]) + (v0[j][2] * v0[j][2] + v0[j][3] * v0[j][3]); s1 += (v1[j][0] * v1[j][0] + v1[j][1] * v1[j][1]) + (v1[j][2] * v1[j][2] + v1[j][3] * v1[j][3]); }
    const float r0 = rsqrtf(wave_sum(s0) * (1.0f / D) + EPS), r1 = rsqrtf(wave_sum(s1) * (1.0f / D) + EPS);
#pragma unroll
    for (int j = 0; j < 4; ++j) { const f32x4 gv = ((const f32x4*)g0)[lane + 64 * j]; const f32x4 o = v0[j] * r0 * gv; u32x2 w; w.x = cvt_pk_bf16(o[0], o[1]); w.y = cvt_pk_bf16(o[2], o[3]); ((u32x2*)(xn + o0 * D))[lane + 64 * j] = w; }
    if (has1) {
#pragma unroll
        for (int j = 0; j < 4; ++j) { const f32x4 gv = ((const f32x4*)g1)[lane + 64 * j]; const f32x4 o = v1[j] * r1 * gv; u32x2 w; w.x = cvt_pk_bf16(o[0], o[1]); w.y = cvt_pk_bf16(o[2], o[3]); ((u32x2*)(xn + o1 * D))[lane + 64 * j] = w; }
    }
}
__device__ __forceinline__ void phase_prep(const Args& a, LAS unsigned char* lds, int G) {
    int tid_ = threadIdx.x; asm volatile("" : "+v"(tid_)); const int tid = tid_, lane = tid & 63, wave = tid >> 6;
    const int gw = blockIdx.x * 8 + wave, NGW = G * 8;
    unsigned char* ws = a.ws;
    LAS float* scr = (LAS float*)(lds + wave * 16384);
    bf16* wcat = (bf16*)(ws + WS_WCAT);
    constexpr int NITEMS = 16 * 80 + 5 * 16 * 32 + 16 * 128 + 64 * 32;
    for (int it = gw; it < NITEMS; it += 2 * NGW) {
        const bool has1 = it + NGW < NITEMS;
        const TItem t0 = titem_decode(a, it), t1 = titem_decode(a, has1 ? it + NGW : it);
        f32x4 v0[8], v1[8];
        titem_load(t0, v0, lane); titem_load(t1, v1, lane);
        titem_store(t0, v0, scr, lane);
        if (has1) titem_store(t1, v1, scr, lane);
    }
    for (int idx = blockIdx.x * 512 + tid; idx < 256 * 1024; idx += G * 512) {
        const int j = idx >> 10, k = idx & 1023; const f32x4* wr = (const f32x4*)(a.in[8] + (size_t)k * 2576 + 2560); float s = 0.f;
        const f32x4 w0 = wr[0], w1 = wr[1], w2 = wr[2], w3 = wr[3];
        const float wv[16] = {w0[0], w0[1], w0[2], w0[3], w1[0], w1[1], w1[2], w1[3], w2[0], w2[1], w2[2], w2[3], w3[0], w3[1], w3[2], w3[3]};
#pragma unroll
        for (int r = 0; r < 16; ++r) s += wv[r] * a.in[9][r * 256 + j];
        wcat[(size_t)(2560 + j) * D + k] = f2bf(s);
    }
    bf16* xn = (bf16*)(ws + WS_XN);
    for (int m = gw; m < NROW + 2048; m += 2 * NGW) norm_rows2(a, m, m + NGW, m + NGW < NROW + 2048, xn, lane);
}

__device__ __forceinline__ void conv_prompt_unit(LAS unsigned char* lds, const Args& a, int unit) {
    int tid_ = threadIdx.x; asm volatile("" : "+v"(tid_)); const int tid = tid_, lane = tid & 63, w = tid >> 6;
    const int b = unit >> 6, t0 = (unit & 63) * 32;
    const bf16* proj = (const bf16*)(a.ws + WS_PROJ); bf16* mix = (bf16*)(a.ws + WS_MIX);
    LAS bf16* in = (LAS bf16*)lds; LAS float* y = (LAS float*)(lds + 65536);
    __syncthreads();
#pragma unroll
    for (int it = 0; it < 8; ++it) { const int row = w + 8 * it; if (row < 62) { const int t = t0 - 30 + row; u32x4 v = {0u, 0u, 0u, 0u};
        if (t >= 0) v = *(const u32x4*)(proj + (size_t)(b * TSEQ + t) * PJ + 8 * lane); *(LAS u32x4*)(in + row * 512 + 8 * lane) = v; } }
    const int c = 64 * w + lane;
    float wgt[31];
#pragma unroll
    for (int k = 0; k < 31; ++k) wgt[k] = a.in[11][k * 512 + c];
    const float bias = a.in[12][c];
    __syncthreads();
    for (int tq = 0; tq < 8; ++tq) {
        float x[34];
#pragma unroll
        for (int k = 0; k < 34; ++k) x[k] = bf2f(in[(4 * tq + k) * 512 + c]);
        float a0 = bias, a1 = bias, a2 = bias, a3 = bias;
#pragma unroll
        for (int k = 0; k < 31; ++k) { a0 += wgt[k] * x[k]; a1 += wgt[k] * x[k + 1]; a2 += wgt[k] * x[k + 2]; a3 += wgt[k] * x[k + 3]; }
        y[(4 * tq + 0) * 512 + c] = a0; y[(4 * tq + 1) * 512 + c] = a1; y[(4 * tq + 2) * 512 + c] = a2; y[(4 * tq + 3) * 512 + c] = a3;
    }
    __syncthreads();
    const f32x4 g0 = *(const f32x4*)(a.in[13] + 8 * lane), g1 = *(const f32x4*)(a.in[13] + 8 * lane + 4), b0 = *(const f32x4*)(a.in[14] + 8 * lane), b1 = *(const f32x4*)(a.in[14] + 8 * lane + 4);
#pragma unroll
    for (int k = 0; k < 4; ++k) {
        const int t = w + 8 * k;
        f32x4 v0 = *(LAS f32x4*)(y + t * 512 + 8 * lane), v1 = *(LAS f32x4*)(y + t * 512 + 8 * lane + 4);
        const float mean = wave_sum((v0[0] + v0[1]) + (v0[2] + v0[3]) + (v1[0] + v1[1]) + (v1[2] + v1[3])) * (1.0f / 512.0f);
        v0 = v0 - mean; v1 = v1 - mean;
        const float var = wave_sum((v0[0] * v0[0] + v0[1] * v0[1]) + (v0[2] * v0[2] + v0[3] * v0[3]) + (v1[0] * v1[0] + v1[1] * v1[1]) + (v1[2] * v1[2] + v1[3] * v1[3])) * (1.0f / 512.0f);
        const float rstd = rsqrtf(var + EPS);
        v0 = v0 * rstd * g0 + b0; v1 = v1 * rstd * g1 + b1;
#pragma unroll
        for (int j = 0; j < 4; ++j) { v0[j] = siluf_(v0[j]); v1[j] = siluf_(v1[j]); }
        *(u32x4*)(mix + (size_t)(b * TSEQ + t0 + t) * D + 8 * lane) = pack8(v0, v1);
    }
}
__device__ __forceinline__ void conv_sample_unit(LAS unsigned char* lds, const Args& a, int b) {
    int tid_ = threadIdx.x; asm volatile("" : "+v"(tid_)); const int tid = tid_, lane = tid & 63, w = tid >> 6, c = tid;
    const bf16* proj = (const bf16*)(a.ws + WS_PROJ); bf16* mix = (bf16*)(a.ws + WS_MIX);
    LAS float* red = (LAS float*)lds;
    float* cs = a.out + O_CS;
    __syncthreads();
    float acc = a.in[12][c];
#pragma unroll 6
    for (int k = 0; k < 30; ++k) { const float v = a.in[2][(size_t)(b * 30 + k) * 512 + c]; acc += a.in[11][k * 512 + c] * v; if (k >= 1) cs[(size_t)(b * 30 + k - 1) * 512 + c] = v; }
    acc += a.in[11][30 * 512 + c] * bf2f(proj[(size_t)(NP + b) * PJ + c]);
    float s = wave_sum(acc); if (lane == 0) red[w] = s;
    __syncthreads();
    float mean = 0.f;
#pragma unroll
    for (int i = 0; i < 8; ++i) mean += red[i];
    mean *= (1.0f / 512.0f);
    const float dv = acc - mean;
    s = wave_sum(dv * dv); if (lane == 0) red[8 + w] = s;
    __syncthreads();
    float var = 0.f;
#pragma unroll
    for (int i = 0; i < 8; ++i) var += red[8 + i];
    const float o = dv * rsqrtf(var * (1.0f / 512.0f) + EPS) * a.in[13][c] + a.in[14][c];
    mix[(size_t)(NP + b) * D + c] = f2bf(siluf_(o));
}
__device__ __forceinline__ void gla1_unit(LAS unsigned char* lds, const Args& a, int unit) {
    int tid_ = threadIdx.x; asm volatile("" : "+v"(tid_)); const int tid = tid_, lane = tid & 63, w = tid >> 6;
    const int bh = unit >> 5, n = unit & 31, b = bh >> 2, h = bh & 3, r0 = b * TSEQ + n * CH;
    const bf16* proj = (const bf16*)(a.ws + WS_PROJ); const float* la = (const float*)(a.ws + WS_LA); float* lb = (float*)(a.ws + WS_LB); float* kv = (float*)(a.ws + WS_KV); float* dec = (float*)(a.ws + WS_DEC);
    LAS unsigned char* kT = lds; LAS unsigned char* vT = lds + 9216; LAS float* segtot = (LAS float*)(lds + 27648);
    const int d = tid & 63, seg = w;
    __syncthreads();
    float c[8]; float run = 0.f;
#pragma unroll
    for (int j = 0; j < 8; ++j) { run += la[(size_t)(r0 + 8 * seg + j) * 256 + h * 64 + d]; c[j] = run; }
    segtot[seg * 64 + d] = run;
    { const int dv = tid & 127, s4 = tid >> 7; unsigned pk[8];
#pragma unroll
        for (int jj = 0; jj < 8; ++jj) { const unsigned lo = proj[(size_t)(r0 + 16 * s4 + 2 * jj) * PJ + PJ_V + h * 128 + dv], hi = proj[(size_t)(r0 + 16 * s4 + 2 * jj + 1) * PJ + PJ_V + h * 128 + dv]; pk[jj] = lo | (hi << 16); }
        *(LAS u32x4*)(vT + dv * 144 + s4 * 32) = (u32x4){pk[0], pk[1], pk[2], pk[3]}; *(LAS u32x4*)(vT + dv * 144 + s4 * 32 + 16) = (u32x4){pk[4], pk[5], pk[6], pk[7]}; }
    __syncthreads();
    float off = 0.f, tot = 0.f;
#pragma unroll
    for (int s = 0; s < 8; ++s) { const float t = segtot[s * 64 + d]; tot += t; if (s < seg) off += t; }
    float kin[8];
#pragma unroll
    for (int j = 0; j < 8; ++j) { const float bj = c[j] + off; lb[(size_t)(r0 + 8 * seg + j) * 256 + h * 64 + d] = bj;
        kin[j] = bf2f(proj[(size_t)(r0 + 8 * seg + j) * PJ + PJ_K + h * 64 + d]) * __expf(tot - bj); }
    *(LAS u32x4*)(kT + d * 144 + seg * 16) = (u32x4){cvt_pk_bf16(kin[0], kin[1]), cvt_pk_bf16(kin[2], kin[3]), cvt_pk_bf16(kin[4], kin[5]), cvt_pk_bf16(kin[6], kin[7])};
    if (seg == 0) dec[(size_t)(bh * NCHUNK + n) * 64 + d] = __expf(tot);
    __syncthreads();
    const int mb = w >> 2, nb = w & 3, nn = lane & 31, g = lane >> 5;
    f32x16 acc;
#pragma unroll
    for (int i = 0; i < 16; ++i) acc[i] = 0.f;
#pragma unroll
    for (int s = 0; s < 4; ++s) { const bf16x8 af = *(LAS bf16x8*)(kT + (32 * mb + nn) * 144 + (16 * s + 8 * g) * 2), bfv = *(LAS bf16x8*)(vT + (32 * nb + nn) * 144 + (16 * s + 8 * g) * 2);
        acc = __builtin_amdgcn_mfma_f32_32x32x16_bf16(af, bfv, acc, 0, 0, 0); }
#pragma unroll
    for (int i = 0; i < 16; ++i) { const int dd = 32 * mb + 8 * (i >> 2) + 4 * g + (i & 3); kv[((size_t)(bh * NCHUNK + n) * 64 + dd) * 128 + 32 * nb + nn] = acc[i]; }
}
__device__ __forceinline__ void gla_sample_unit(LAS unsigned char* lds, const Args& a, int unit) {
    int tid_ = threadIdx.x; asm volatile("" : "+v"(tid_)); const int tid = tid_, lane = tid & 63, w = tid >> 6;
    const int b = unit >> 2, h = unit & 3, row = NP + b;
    const bf16* proj = (const bf16*)(a.ws + WS_PROJ); const float* la = (const float*)(a.ws + WS_LA); bf16* mix = (bf16*)(a.ws + WS_MIX);
    LAS float* red = (LAS float*)lds;
    LAS float* red2 = red + 2048;
    const int dv = 4 * (tid & 31), dg = tid >> 5;
    __syncthreads();
    const u32x2 vv = *(const u32x2*)(proj + (size_t)row * PJ + PJ_V + h * 128 + dv);
    const f32x4 v4 = {bflo(vv.x), bfhi(vv.x), bflo(vv.y), bfhi(vv.y)};
    f32x4 o4 = {0.f, 0.f, 0.f, 0.f};
#pragma unroll
    for (int dd = 0; dd < 4; ++dd) { const int d = 4 * dg + dd;
        const float al = __expf(la[(size_t)row * 256 + h * 64 + d]), kk = bf2f(proj[(size_t)row * PJ + PJ_K + h * 64 + d]), qq = bf2f(proj[(size_t)row * PJ + PJ_Q + h * 64 + d]);
        const size_t so = ((size_t)(b * 4 + h) * 64 + d) * 128 + dv;
        const f32x4 sn = *(const f32x4*)(a.in[3] + so) * al + v4 * kk;
        *(f32x4*)(a.out + O_GS + so) = sn; o4 = o4 + sn * qq; }
    *(LAS f32x4*)(red + dg * 128 + dv) = o4;
    __syncthreads();
    float o = 0.f;
    if (tid < 128) {
#pragma unroll
        for (int i = 0; i < 16; ++i) o += red[i * 128 + tid];
        const float ss = wave_sum(o * o); if (lane == 0) red2[w] = ss;
    }
    __syncthreads();
    if (tid < 128) { const float rstd = rsqrtf((red2[0] + red2[1]) * (1.0f / 128.0f) + EPS);
        mix[(size_t)row * D + 512 + h * 128 + tid] = f2bf(o * rstd * a.in[15][tid] * bf2f(proj[(size_t)row * PJ + PJ_R + h * 128 + tid])); }
}
__device__ __forceinline__ void vt_unit(const Args& a, int unit) {
    int tid_ = threadIdx.x; asm volatile("" : "+v"(tid_)); const int tid = tid_, b = unit >> 2, h = unit & 3, hd = tid & 255, ms = tid >> 8;
    const bf16* mvb = (const bf16*)(a.ws + WS_MVB); bf16* mvt = (bf16*)(a.ws + WS_MVT);
    for (int mc = 0; mc < 16; ++mc) { const int m0 = ms * 128 + mc * 8; unsigned pk[4];
#pragma unroll
        for (int j = 0; j < 4; ++j) { const unsigned lo = mvb[(size_t)(b * 256 + m0 + 2 * j) * D + h * 256 + hd], hi = mvb[(size_t)(b * 256 + m0 + 2 * j + 1) * D + h * 256 + hd]; pk[j] = lo | (hi << 16); }
        *(u32x4*)(mvt + ((size_t)(b * 4 + h) * 256 + hd) * 256 + m0) = (u32x4){pk[0], pk[1], pk[2], pk[3]}; }
}

__device__ __forceinline__ void phase_scan(const Args& a, int G) {
    const float* kv = (const float*)(a.ws + WS_KV); const float* dec = (const float*)(a.ws + WS_DEC); bf16* sb = (bf16*)(a.ws + WS_SB);
    typedef float f32x2 __attribute__((ext_vector_type(2)));
    for (int p = blockIdx.x * 512 + threadIdx.x; p < 32 * 4096; p += G * 512) {
        const int bh = p >> 12, e = (p & 4095) * 2, d = e >> 7;
        f32x2 S = {0.f, 0.f};
#pragma unroll 8
        for (int n = 0; n < NCHUNK; ++n) {
            const size_t o = (size_t)(bh * NCHUNK + n) * 8192 + e;
            const f32x2 k2 = *(const f32x2*)(kv + o); const float dc = dec[(size_t)(bh * NCHUNK + n) * 64 + d];
            *(unsigned*)(sb + o) = cvt_pk_bf16(S[0], S[1]);
            S = S * dc + k2;
        }
        *(f32x2*)(a.out + O_GP + (size_t)bh * 8192 + e) = S;
    }
}

__device__ __forceinline__ void gla3_unit(LAS unsigned char* lds, const Args& a, int unit) {
    int tid_ = threadIdx.x; asm volatile("" : "+v"(tid_)); const int tid = tid_, lane = tid & 63, w = tid >> 6;
    const int bh = unit >> 5, n = unit & 31, b = bh >> 2, h = bh & 3, r0 = b * TSEQ + n * CH;
    const bf16* proj = (const bf16*)(a.ws + WS_PROJ); const float* la = (const float*)(a.ws + WS_LB); const bf16* sb = (const bf16*)(a.ws + WS_SB); bf16* mix = (bf16*)(a.ws + WS_MIX);
    LAS unsigned char* vT = lds; LAS unsigned char* sT = lds + 18432; LAS unsigned char* P = lds + 36864; LAS unsigned char* qin = lds + 46080; LAS unsigned char* kt = lds + 55296;
    LAS float* O = (LAS float*)(lds + 64512);
    __syncthreads();
    { const int d = tid & 63, seg = w;
#pragma unroll
        for (int j = 0; j < 8; ++j) { const int t = 8 * seg + j; const float bb = la[(size_t)(r0 + t) * 256 + h * 64 + d];
            const float q = bf2f(proj[(size_t)(r0 + t) * PJ + PJ_Q + h * 64 + d]), k = bf2f(proj[(size_t)(r0 + t) * PJ + PJ_K + h * 64 + d]);
            *(LAS bf16*)(qin + t * 144 + d * 2) = f2bf(q * __expf(bb)); *(LAS bf16*)(kt + t * 144 + d * 2) = f2bf(k * __expf(-bb)); } }
    { const int dv = tid & 127, s4 = tid >> 7; unsigned pk[8];
#pragma unroll
        for (int jj = 0; jj < 8; ++jj) { const unsigned lo = proj[(size_t)(r0 + 16 * s4 + 2 * jj) * PJ + PJ_V + h * 128 + dv], hi = proj[(size_t)(r0 + 16 * s4 + 2 * jj + 1) * PJ + PJ_V + h * 128 + dv]; pk[jj] = lo | (hi << 16); }
        *(LAS u32x4*)(vT + dv * 144 + s4 * 32) = (u32x4){pk[0], pk[1], pk[2], pk[3]}; *(LAS u32x4*)(vT + dv * 144 + s4 * 32 + 16) = (u32x4){pk[4], pk[5], pk[6], pk[7]};
        const bf16* sp = sb + (size_t)(bh * NCHUNK + n) * 8192;
#pragma unroll
        for (int jj = 0; jj < 8; ++jj) { const unsigned lo = sp[(16 * s4 + 2 * jj) * 128 + dv], hi = sp[(16 * s4 + 2 * jj + 1) * 128 + dv]; pk[jj] = lo | (hi << 16); }
        *(LAS u32x4*)(sT + dv * 144 + s4 * 32) = (u32x4){pk[0], pk[1], pk[2], pk[3]}; *(LAS u32x4*)(sT + dv * 144 + s4 * 32 + 16) = (u32x4){pk[4], pk[5], pk[6], pk[7]}; }
    __syncthreads();
    const int nn = lane & 31, g = lane >> 5;
    if (w < 4) { const int ib = w >> 1, jb = w & 1;
        f32x16 acc;
#pragma unroll
        for (int i = 0; i < 16; ++i) acc[i] = 0.f;
#pragma unroll
        for (int s = 0; s < 4; ++s) { const bf16x8 af = *(LAS bf16x8*)(qin + (32 * ib + nn) * 144 + (16 * s + 8 * g) * 2), bfv = *(LAS bf16x8*)(kt + (32 * jb + nn) * 144 + (16 * s + 8 * g) * 2);
            acc = __builtin_amdgcn_mfma_f32_32x32x16_bf16(af, bfv, acc, 0, 0, 0); }
#pragma unroll
        for (int i = 0; i < 16; ++i) { const int ii = 32 * ib + 8 * (i >> 2) + 4 * g + (i & 3), jj = 32 * jb + nn; *(LAS bf16*)(P + ii * 144 + jj * 2) = f2bf(jj <= ii ? acc[i] : 0.f); } }
    __syncthreads();
    { const int ib = w >> 2, nb = w & 3;
        f32x16 acc;
#pragma unroll
        for (int i = 0; i < 16; ++i) acc[i] = 0.f;
#pragma unroll
        for (int s = 0; s < 4; ++s) { const bf16x8 af = *(LAS bf16x8*)(P + (32 * ib + nn) * 144 + (16 * s + 8 * g) * 2), bfv = *(LAS bf16x8*)(vT + (32 * nb + nn) * 144 + (16 * s + 8 * g) * 2);
            acc = __builtin_amdgcn_mfma_f32_32x32x16_bf16(af, bfv, acc, 0, 0, 0); }
#pragma unroll
        for (int s = 0; s < 4; ++s) { const bf16x8 af = *(LAS bf16x8*)(qin + (32 * ib + nn) * 144 + (16 * s + 8 * g) * 2), bfv = *(LAS bf16x8*)(sT + (32 * nb + nn) * 144 + (16 * s + 8 * g) * 2);
            acc = __builtin_amdgcn_mfma_f32_32x32x16_bf16(af, bfv, acc, 0, 0, 0); }
#pragma unroll
        for (int i = 0; i < 16; ++i) { const int ii = 32 * ib + 8 * (i >> 2) + 4 * g + (i & 3); O[ii * 132 + 32 * nb + nn] = acc[i]; } }
    __syncthreads();
    { const int i = tid >> 3, part = tid & 7; f32x4 o[4]; float ss = 0.f;
#pragma unroll
        for (int j = 0; j < 4; ++j) { o[j] = *(LAS f32x4*)(O + i * 132 + 16 * part + 4 * j); ss += (o[j][0] * o[j][0] + o[j][1] * o[j][1]) + (o[j][2] * o[j][2] + o[j][3] * o[j][3]); }
        ss += __shfl_xor(ss, 1); ss += __shfl_xor(ss, 2); ss += __shfl_xor(ss, 4);
        const float rstd = rsqrtf(ss * (1.0f / 128.0f) + EPS);
        const size_t row = (size_t)(r0 + i);
        const u32x4 r0v = *(const u32x4*)(proj + row * PJ + PJ_R + h * 128 + 16 * part), r1v = *(const u32x4*)(proj + row * PJ + PJ_R + h * 128 + 16 * part + 8);
        const float* gg = a.in[15] + 16 * part;
        const unsigned rw[8] = {r0v.x, r0v.y, r0v.z, r0v.w, r1v.x, r1v.y, r1v.z, r1v.w};
        unsigned ow[8];
#pragma unroll
        for (int j = 0; j < 8; ++j) { const float x0 = o[j >> 1][(j & 1) * 2] * rstd * gg[2 * j] * bflo(rw[j]), x1 = o[j >> 1][(j & 1) * 2 + 1] * rstd * gg[2 * j + 1] * bfhi(rw[j]); ow[j] = cvt_pk_bf16(x0, x1); }
        bf16* op = mix + row * D + 512 + h * 128 + 16 * part;
        *(u32x4*)op = (u32x4){ow[0], ow[1], ow[2], ow[3]}; *(u32x4*)(op + 8) = (u32x4){ow[4], ow[5], ow[6], ow[7]}; }
}

__device__ __forceinline__ void attn_prompt_unit(LAS unsigned char* lds, const Args& a, int unit) {
    int tid_ = threadIdx.x; asm volatile("" : "+v"(tid_)); const int tid = tid_, lane = tid & 63, w = tid >> 6, nn = lane & 31, g = lane >> 5;
    const int b = unit >> 5, h = (unit >> 3) & 3, qt = unit & 7;
    const bf16* qx = (const bf16*)(a.ws + WS_QX); const bf16* mkb = (const bf16*)(a.ws + WS_MKB); const bf16* mvt = (const bf16*)(a.ws + WS_MVT); bf16* ao = (bf16*)(a.ws + WS_AO);
    const size_t qrow = (size_t)b * TSEQ + qt * 256 + 32 * w + nn;
    __syncthreads();
#pragma unroll 4
    for (int it = 0; it < 16; ++it) { const int row = (tid >> 5) + 16 * it, ch = tid & 31;
        *(LAS u32x4*)(lds + row * 528 + ch * 16) = *(const u32x4*)(mkb + (size_t)(b * 256 + row) * D + h * 256 + ch * 8); }
    bf16x8 qf[16];
#pragma unroll
    for (int s = 0; s < 16; ++s) qf[s] = *(const bf16x8*)(qx + qrow * D + h * 256 + 16 * s + 8 * g);
    __syncthreads();
    f32x16 acc[8];
#pragma unroll
    for (int kb = 0; kb < 8; ++kb) {
#pragma unroll
        for (int i = 0; i < 16; ++i) acc[kb][i] = 0.f;
#pragma unroll
        for (int s = 0; s < 16; ++s) { const bf16x8 af = *(LAS bf16x8*)(lds + (32 * kb + nn) * 528 + (16 * s + 8 * g) * 2); acc[kb] = __builtin_amdgcn_mfma_f32_32x32x16_bf16(af, qf[s], acc[kb], 0, 0, 0); }
    }
    float mx = -3.0e38f;
#pragma unroll
    for (int kb = 0; kb < 8; ++kb)
#pragma unroll
        for (int i = 0; i < 16; ++i) mx = fmaxf(mx, acc[kb][i]);
    mx = fmaxf(mx, __shfl_xor(mx, 32));
    float sum = 0.f;
    u32x4 pb[8][2];
#pragma unroll
    for (int kb = 0; kb < 8; ++kb) {
#pragma unroll
        for (int i = 0; i < 16; ++i) { const float p = __expf(acc[kb][i] - mx); sum += p; acc[kb][i] = p; }
#pragma unroll
        for (int hh = 0; hh < 2; ++hh) { pb[kb][hh].x = cvt_pk_bf16(acc[kb][8 * hh + 0], acc[kb][8 * hh + 1]); pb[kb][hh].y = cvt_pk_bf16(acc[kb][8 * hh + 2], acc[kb][8 * hh + 3]);
            pb[kb][hh].z = cvt_pk_bf16(acc[kb][8 * hh + 4], acc[kb][8 * hh + 5]); pb[kb][hh].w = cvt_pk_bf16(acc[kb][8 * hh + 6], acc[kb][8 * hh + 7]); }
    }
    sum += __shfl_xor(sum, 32);
    const float inv = 1.0f / sum;
    __syncthreads();
#pragma unroll 4
    for (int it = 0; it < 16; ++it) { const int row = (tid >> 5) + 16 * it, ch = tid & 31;
        *(LAS u32x4*)(lds + row * 528 + ch * 16) = *(const u32x4*)(mvt + ((size_t)(b * 4 + h) * 256 + row) * 256 + ch * 8); }
    __syncthreads();
#pragma unroll
    for (int mb = 0; mb < 8; ++mb) {
        f32x16 o;
#pragma unroll
        for (int i = 0; i < 16; ++i) o[i] = 0.f;
#pragma unroll
        for (int kb = 0; kb < 8; ++kb)
#pragma unroll
            for (int hh = 0; hh < 2; ++hh) { const int base = 32 * kb + 16 * hh;
                const u32x2 lo = *(LAS u32x2*)(lds + (32 * mb + nn) * 528 + (base + 4 * g) * 2), hi = *(LAS u32x2*)(lds + (32 * mb + nn) * 528 + (base + 8 + 4 * g) * 2);
                const u32x4 av = {lo.x, lo.y, hi.x, hi.y};
                o = __builtin_amdgcn_mfma_f32_32x32x16_bf16(__builtin_bit_cast(bf16x8, av), __builtin_bit_cast(bf16x8, pb[kb][hh]), o, 0, 0, 0); }
#pragma unroll
        for (int i4 = 0; i4 < 4; ++i4) { u32x2 wv; wv.x = cvt_pk_bf16(o[4 * i4] * inv, o[4 * i4 + 1] * inv); wv.y = cvt_pk_bf16(o[4 * i4 + 2] * inv, o[4 * i4 + 3] * inv);
            *(u32x2*)(ao + qrow * D + h * 256 + 32 * mb + 8 * i4 + 4 * g) = wv; }
    }
}
__device__ __forceinline__ float reduce16(float (&p)[16], int lane) {
    float q8[8], q4[4], q2[2];
    const bool b5 = lane & 32, b4 = lane & 16, b3 = lane & 8, b2 = lane & 4;
#pragma unroll
    for (int j = 0; j < 8; ++j) { const float keep = b5 ? p[j + 8] : p[j], send = b5 ? p[j] : p[j + 8]; q8[j] = keep + __shfl_xor(send, 32); }
#pragma unroll
    for (int j = 0; j < 4; ++j) { const float keep = b4 ? q8[j + 4] : q8[j], send = b4 ? q8[j] : q8[j + 4]; q4[j] = keep + __shfl_xor(send, 16); }
#pragma unroll
    for (int j = 0; j < 2; ++j) { const float keep = b3 ? q4[j + 2] : q4[j], send = b3 ? q4[j] : q4[j + 2]; q2[j] = keep + __shfl_xor(send, 8); }
    const float keep = b2 ? q2[1] : q2[0], send = b2 ? q2[0] : q2[1];
    float r = keep + __shfl_xor(send, 4);
    r += __shfl_xor(r, 1); r += __shfl_xor(r, 2);
    return r;
}
__device__ __forceinline__ void attn_sample_unit(LAS unsigned char* lds, const Args& a, int unit) {
    int tid_ = threadIdx.x; asm volatile("" : "+v"(tid_)); const int tid = tid_, lane = tid & 63, w = tid >> 6;
    const int b = unit >> 2, h = unit & 3;
    const bf16* qx = (const bf16*)(a.ws + WS_QX); bf16* ao = (bf16*)(a.ws + WS_AO);
    LAS float* sc = (LAS float*)lds; LAS float* red = sc + 256;
    const u32x2 qq = *(const u32x2*)(qx + (size_t)(NP + b) * D + h * 256 + 4 * lane);
    const f32x4 q4 = {bflo(qq.x), bfhi(qq.x), bflo(qq.y), bfhi(qq.y)};
    const float* kbase = a.in[4] + ((size_t)b * 256 * 4 + h) * 256 + 4 * lane + (size_t)(32 * w) * 1024;
    const float* vbase = a.in[5] + ((size_t)b * 256 * 4 + h) * 256 + 4 * lane + (size_t)(32 * w) * 1024;
    __syncthreads();
#pragma unroll 1
    for (int c = 0; c < 2; ++c) {
        f32x4 kv[16]; float p[16];
#pragma unroll
        for (int j = 0; j < 16; ++j) kv[j] = __builtin_nontemporal_load((const f32x4*)(kbase + (size_t)(16 * c + j) * 1024));
#pragma unroll
        for (int j = 0; j < 16; ++j) p[j] = (kv[j][0] * q4[0] + kv[j][1] * q4[1]) + (kv[j][2] * q4[2] + kv[j][3] * q4[3]);
        const float r = reduce16(p, lane);
        if ((lane & 3) == 0) sc[32 * w + 16 * c + ((lane >> 5) & 1) * 8 + ((lane >> 4) & 1) * 4 + ((lane >> 3) & 1) * 2 + ((lane >> 2) & 1)] = r;
    }
    __syncthreads();
    const float s0 = sc[lane], s1 = sc[64 + lane], s2 = sc[128 + lane], s3 = sc[192 + lane];
    const float mx = wave_max(fmaxf(fmaxf(s0, s1), fmaxf(s2, s3)));
    const float inv = 1.0f / wave_sum((__expf(s0 - mx) + __expf(s1 - mx)) + (__expf(s2 - mx) + __expf(s3 - mx)));
    f32x4 o4 = {0.f, 0.f, 0.f, 0.f};
#pragma unroll 1
    for (int c = 0; c < 2; ++c) {
        f32x4 vv[16];
#pragma unroll
        for (int j = 0; j < 16; ++j) vv[j] = __builtin_nontemporal_load((const f32x4*)(vbase + (size_t)(16 * c + j) * 1024));
#pragma unroll
        for (int j = 0; j < 16; ++j) { const float p = __expf(sc[32 * w + 16 * c + j] - mx) * inv; o4 = o4 + vv[j] * p; }
    }
    *(LAS f32x4*)(red + w * 256 + 4 * lane) = o4;
    __syncthreads();
    if (tid < 256) { float o = 0.f;
#pragma unroll
        for (int i = 0; i < 8; ++i) o += red[i * 256 + tid];
        ao[(size_t)(NP + b) * D + h * 256 + tid] = f2bf(o); }
}

__device__ __forceinline__ void phase_final(const Args& a, int G) {
    int tid_ = threadIdx.x; asm volatile("" : "+v"(tid_)); const int tid = tid_, lane = tid & 63, wave = tid >> 6;
    const float* part = (const float*)(a.ws + WS_PART + 2 * PART_BYTES); const float* spart = (const float*)(a.ws + WS_SPART + 2 * SPART_BYTES);
    for (int m = blockIdx.x * 8 + wave; m < NROW; m += G * 8) {
        float* y = a.out + (m < NP ? O_YP + (size_t)m * D : O_YS + (size_t)(m - NP) * D);
        const float pv = m < NP ? (lane < 16 ? part[(size_t)m * 16 + lane] : 0.f) : (lane < 32 ? spart[(size_t)(m - NP) * 32 + lane] : 0.f);
        const float rstd = rsqrtf(wave_sum(pv) * (1.0f / D) + EPS);
#pragma unroll
        for (int j = 0; j < 4; ++j) { const f32x4 gv = ((const f32x4*)a.in[26])[lane + 64 * j]; f32x4 v = ((f32x4*)y)[lane + 64 * j]; ((f32x4*)y)[lane + 64 * j] = v * rstd * gv; }
    }
}

__global__ void __launch_bounds__(512, 2) hybrid_fwd(Args a) {
    extern __shared__ __attribute__((aligned(16))) unsigned char lds_raw[];
    LAS unsigned char* lds = (LAS unsigned char*)lds_raw;
    cg::grid_group grid = cg::this_grid();
    const int G = gridDim.x, bx = blockIdx.x;
    unsigned char* ws = a.ws;
    const int lo = a.ph_lo, hi = a.ph_hi;
    volatile LAS unsigned* bst = (volatile LAS unsigned*)(lds + LDS_BYTES - 64);
    if (threadIdx.x < 2) bst[threadIdx.x] = 0u;
    __syncthreads();
    XcdBarrier bar = xcd_barrier_post((unsigned*)ws, bst);
    if (lo < 0) grid.sync();
#define IN(k) (lo <= (k) && (k) < hi)
#ifndef PROBE_PHASE
#define PROBE_PHASE -1
#endif
#define REPS(k) for (int rp_ = 0; rp_ < ((k) == PROBE_PHASE ? 2 : 1); ++rp_, ((rp_ < ((k) == PROBE_PHASE ? 2 : 1)) ? xcd_barrier(bar) : (void)0))
#define SEAM(k) do { if (IN(k) && IN((k) + 1)) xcd_barrier(bar); } while (0)

    REPS(0) if (IN(0)) phase_prep(a, lds, G);
    SEAM(0);
    REPS(1) if (IN(1)) {
        __syncthreads();
        { SEpiG1 SE{(bf16*)(ws + WS_PROJ), (float*)(ws + WS_LA), a.in[10], a.out + O_CS};
          sgemm_phase(lds, (const bf16*)(ws + WS_XN) + (size_t)NP * D, (const bf16*)(ws + WS_WCAT), D, 8 * 88, SE, G); }
        pg8::Gemm g{(const bf16*)(ws + WS_XN), (const bf16*)(ws + WS_WCAT), 0, 0, D}; OrderRect S; S.init(64, 11, G, bx, 8, 8, 65, 11);
        EpiG1 E{(bf16*)(ws + WS_PROJ), (float*)(ws + WS_LA), a.in[10], a.out + O_CP, a.out + O_CS, a.out + O_MK, a.out + O_MV, (bf16*)(ws + WS_MKB), (bf16*)(ws + WS_MVB)};
        pg8::gemm_phase<EpiG1, OrderRect, true, true>(lds, g, S, E);
    }
    SEAM(1);
    REPS(2) if (IN(2)) {
        constexpr int U_CONV = 512, U_G1 = 1024, U_CS = 128, U_GS = 512, U_VT = 32, U_ALL = U_CONV + U_G1 + U_CS + U_GS + U_VT;
        for (int u = bx; u < U_ALL; u += G) {
            int r = u;
            if (r < U_G1) { gla1_unit(lds, a, r); continue; } r -= U_G1;
            if (r < U_CONV) { conv_prompt_unit(lds, a, r); continue; } r -= U_CONV;
            if (r < U_GS) { gla_sample_unit(lds, a, r); continue; } r -= U_GS;
            if (r < U_CS) { conv_sample_unit(lds, a, r); continue; } r -= U_CS;
            vt_unit(a, r);
        }
    }
    SEAM(2);
    REPS(3) if (IN(3)) phase_scan(a, G);
    SEAM(3);
    REPS(4) if (IN(4)) { for (int u = bx; u < 1024; u += G) gla3_unit(lds, a, u); }
    SEAM(4);
    REPS(5) if (IN(5)) {
        __syncthreads();
        { SEpiRes SE{a.in[1], (float*)(ws + WS_X1) + (size_t)NP * D, (bf16*)(ws + WS_XB) + (size_t)NP * D, (float*)(ws + WS_SPART)};
          sgemm_phase(lds, (const bf16*)(ws + WS_MIX) + (size_t)NP * D, (const bf16*)(ws + WS_WOUT), D, 8 * 32, SE, G); }
        pg8::Gemm g{(const bf16*)(ws + WS_MIX), (const bf16*)(ws + WS_WOUT), 0, 0, D}; OrderRect S; S.init(64, 4, G, bx);
        EpiRes E{a.in[0], a.in[1], (float*)(ws + WS_X1), (float*)(ws + WS_X1) + (size_t)NP * D, (bf16*)(ws + WS_XB), (float*)(ws + WS_PART)};
        pg8::gemm_phase<EpiRes, OrderRect, true, true>(lds, g, S, E);
    }
    SEAM(5);
    REPS(6) if (IN(6)) {
        __syncthreads();
        { SEpiScale<0> SE{(const float*)(ws + WS_SPART), (bf16*)(ws + WS_QX) + (size_t)NP * D, D};
          sgemm_phase(lds, (const bf16*)(ws + WS_XB) + (size_t)NP * D, (const bf16*)(ws + WS_WXQ), D, 8 * 32, SE, G); }
        pg8::Gemm g{(const bf16*)(ws + WS_XB), (const bf16*)(ws + WS_WXQ), 0, 0, D}; OrderRect S; S.init(64, 4, G, bx);
        EpiScale<0> E{(const float*)(ws + WS_PART), (bf16*)(ws + WS_QX), D};
        pg8::gemm_phase<EpiScale<0>, OrderRect, true, true>(lds, g, S, E);
    }
    SEAM(6);
    REPS(7) if (IN(7)) {
        for (int u = bx; u < 256 + 512; u += G) { if (u < 256) attn_prompt_unit(lds, a, u); else attn_sample_unit(lds, a, u - 256); }
    }
    SEAM(7);
    REPS(8) if (IN(8)) {
        __syncthreads();
        float* x1 = (float*)(ws + WS_X1);
        { SEpiRes SE{x1 + (size_t)NP * D, x1 + (size_t)NP * D, (bf16*)(ws + WS_XB) + (size_t)NP * D, (float*)(ws + WS_SPART + SPART_BYTES)};
          sgemm_phase(lds, (const bf16*)(ws + WS_AO) + (size_t)NP * D, (const bf16*)(ws + WS_WXO), D, 8 * 32, SE, G); }
        pg8::Gemm g{(const bf16*)(ws + WS_AO), (const bf16*)(ws + WS_WXO), 0, 0, D}; OrderRect S; S.init(64, 4, G, bx);
        EpiRes E{x1, x1 + (size_t)NP * D, x1, x1 + (size_t)NP * D, (bf16*)(ws + WS_XB), (float*)(ws + WS_PART + PART_BYTES)};
        pg8::gemm_phase<EpiRes, OrderRect, true, true>(lds, g, S, E);
    }
    SEAM(8);
    REPS(9) if (IN(9)) {
        __syncthreads();
        { SEpiScale<1> SE{(const float*)(ws + WS_SPART + SPART_BYTES), (bf16*)(ws + WS_HB) + (size_t)NP * FF, FF};
          sgemm_phase(lds, (const bf16*)(ws + WS_XB) + (size_t)NP * D, (const bf16*)(ws + WS_WUP), D, 8 * 128, SE, G); }
        pg8::Gemm g{(const bf16*)(ws + WS_XB), (const bf16*)(ws + WS_WUP), 0, 0, D}; OrderRect S; S.init(64, 16, G, bx);
        EpiScale<1> E{(const float*)(ws + WS_PART + PART_BYTES), (bf16*)(ws + WS_HB), FF};
        pg8::gemm_phase<EpiScale<1>, OrderRect, true, true>(lds, g, S, E);
    }
    SEAM(9);
    REPS(10) if (IN(10)) {
        __syncthreads();
        float* x1 = (float*)(ws + WS_X1);
        { SEpiRes SE{x1 + (size_t)NP * D, a.out + O_YS, nullptr, (float*)(ws + WS_SPART + 2 * SPART_BYTES)};
          sgemm_phase(lds, (const bf16*)(ws + WS_HB) + (size_t)NP * FF, (const bf16*)(ws + WS_WDN), FF, 8 * 32, SE, G); }
        pg8::Gemm g{(const bf16*)(ws + WS_HB), (const bf16*)(ws + WS_WDN), 0, 0, FF}; OrderRect S; S.init(64, 4, G, bx);
        EpiRes E{x1, x1 + (size_t)NP * D, a.out + O_YP, a.out + O_YS, nullptr, (float*)(ws + WS_PART + 2 * PART_BYTES)};
        pg8::gemm_phase<EpiRes, OrderRect, true, true>(lds, g, S, E);
    }
    SEAM(10);
    REPS(11) if (IN(11)) phase_final(a, G);
#undef IN
#undef SEAM
}

#ifndef N_LAUNCHES
#define N_LAUNCHES 1
#endif
extern "C" void kernel_launch(void* const* d_in, const int* in_sizes, int n_in, void* d_out, int out_size, void* d_ws, size_t ws_size, hipStream_t stream) {
    static int grid = 0;
    if (grid == 0) {
        if (n_in != 27 || ws_size < WS_END) { fprintf(stderr, "kernel_launch: unexpected n_in %d / ws %zu\n", n_in, ws_size); grid = -1; return; }
        int dev = 0, cus = 0, per_cu = 0;
        (void)hipGetDevice(&dev); (void)hipDeviceGetAttribute(&cus, hipDeviceAttributeMultiprocessorCount, dev);
        if (hipFuncSetAttribute((const void*)hybrid_fwd, hipFuncAttributeMaxDynamicSharedMemorySize, LDS_BYTES) != hipSuccess) { fprintf(stderr, "kernel_launch: hipFuncSetAttribute failed\n"); grid = -1; return; }
        if (hipOccupancyMaxActiveBlocksPerMultiprocessor(&per_cu, (const void*)hybrid_fwd, 512, LDS_BYTES) != hipSuccess || per_cu < 1) { fprintf(stderr, "kernel_launch: occupancy query says %d\n", per_cu); per_cu = 1; }
        (void)hipGetLastError();
        grid = cus * 1;
        fprintf(stderr, "kernel_launch: grid %d (cus %d, per_cu %d)\n", grid, cus, per_cu);
    }
    if (grid < 0) return;
    if (hipMemsetAsync(d_ws, 0, 16384, stream) != hipSuccess) { fprintf(stderr, "kernel_launch: memset failed\n"); return; }
    Args a{};
    for (int i = 0; i < 27; ++i) a.in[i] = (const float*)d_in[i];
    a.out = (float*)d_out; a.ws = (unsigned char*)d_ws;
    if (N_LAUNCHES == 1) {
        a.ph_lo = 0; a.ph_hi = 12;
        void* args[] = {&a};
        hipError_t e = hipLaunchCooperativeKernel((const void*)hybrid_fwd, dim3(grid), dim3(512), args, LDS_BYTES, stream);
        if (e != hipSuccess) fprintf(stderr, "cooperative launch failed: %s (grid %d)\n", hipGetErrorString(e), grid);
    } else {
        for (int p = 0; p < 12; ++p) { a.ph_lo = p; a.ph_hi = p + 1; hipLaunchKernelGGL(hybrid_fwd, dim3(grid), dim3(512), LDS_BYTES, stream, a); }
    }
}
```
